# Optimizing an MI355X kernel written in HIP

```python
import jax, jax.numpy as jnp
from jax import lax
import numpy as np

D_MODEL = 1024
BATCH = 2
SEQ = 16384
DEPTH = 4

GRID_W = 64
CTX_LEN = 256
HEAD_DIM = 64
RET_HEADS = 4
RET_W = RET_HEADS * HEAD_DIM
ATT_Q_HEADS = 8
ATT_KV_HEADS = 2
ATT_GROUP = ATT_Q_HEADS // ATT_KV_HEADS
ATT_W = ATT_Q_HEADS * HEAD_DIM
KV_W = ATT_KV_HEADS * HEAD_DIM
CM_GROUPS = 4
CM_CH = 64
CM_W = CM_GROUPS * CM_CH
MIX_W = RET_W + ATT_W + CM_W
IN_SPLITS = (RET_W, RET_W, RET_W, RET_W, ATT_W, KV_W, KV_W, CM_W, CM_W)
IN_W = 4 * RET_W + ATT_W + 2 * KV_W + 2 * CM_W
CHUNK = 128
WINDOW = 128
BLOCK = 128
FFN_HID = -(-8 * D_MODEL // (3 * 256)) * 256
ROPE_BASE = 10000.0
AX_PAIRS = HEAD_DIM // 4
EPS = 1e-6

kernel_name = 'hymba_style_retention_swa_gmlp_dit_trunk'

F32 = jnp.float32


def rms_norm(x, g):
    xf = x.astype(F32)
    y = xf * lax.rsqrt(jnp.mean(xf * xf, axis=-1, keepdims=True) + EPS)
    return (y * g.astype(F32)).astype(x.dtype)


def modulate(z, shift, scale):
    return z * (1 + scale) + shift


def split_in(p):
    return jnp.split(p, np.cumsum(IN_SPLITS)[:-1].tolist(), axis=-1)


def axial_rope_tables(n):
    rows = n // GRID_W
    row = jnp.repeat(jnp.arange(rows, dtype=F32), GRID_W)
    col = jnp.tile(jnp.arange(GRID_W, dtype=F32), rows)
    inv = 1.0 / (ROPE_BASE ** (jnp.arange(AX_PAIRS, dtype=F32) / AX_PAIRS))
    ang = jnp.stack([row[:, None] * inv, col[:, None] * inv], axis=1)
    return jnp.cos(ang), jnp.sin(ang)


def apply_rope(x, cos, sin):
    xr = x.astype(F32).reshape(*x.shape[:-1], 2, 2, AX_PAIRS)
    x1, x2 = xr[..., 0, :], xr[..., 1, :]
    cs, sn = cos[:, None], sin[:, None]
    out = jnp.stack([x1 * cs - x2 * sn, x2 * cs + x1 * sn], axis=-2)
    return out.reshape(x.shape).astype(x.dtype)


def retention_scan(q, k, v, log_gamma, s0):
    b, h, n, dk = q.shape
    dv = v.shape[-1]
    nc = n // CHUNK
    to_chunks = lambda t: t.reshape(b, h, nc, CHUNK, t.shape[-1]).transpose(2, 0, 1, 3, 4)
    qc, kc, vc = to_chunks(q), to_chunks(k), to_chunks(v)
    idx = jnp.arange(CHUNK, dtype=F32)
    lg = log_gamma[:, None]
    diff = idx[:, None] - idx[None, :]
    intra = jnp.where(diff >= 0, jnp.exp(lg[:, :, None] * jnp.maximum(diff, 0.0)), 0.0)
    q_decay = jnp.exp(lg * (idx + 1.0))[:, :, None]
    k_decay = jnp.exp(lg * (CHUNK - 1.0 - idx))[:, :, None]
    chunk_decay = jnp.exp(lg[:, 0] * CHUNK)[:, None, None]

    def step(s, inp):
        qi, ki, vi = inp
        sc = jnp.einsum('bhqd,bhkd->bhqk', qi, ki) * intra
        o = jnp.einsum('bhqk,bhkv->bhqv', sc, vi) + jnp.einsum('bhqd,bhdv->bhqv', qi * q_decay, s)
        s = s * chunk_decay + jnp.einsum('bhkd,bhkv->bhdv', ki * k_decay, vi)
        return s, o

    s_final, o = lax.scan(step, s0, (qc, kc, vc))
    return o.transpose(1, 2, 0, 3, 4).reshape(b, h, n, dv), s_final


def retention_mixer(q, k, v, gate, decay_f, decay_b, norm_g, s0_f, s0_b, rope):
    b, n, _ = q.shape
    shp = (b, n, RET_HEADS, HEAD_DIM)
    q, k, v = q.reshape(shp), k.reshape(shp) * (HEAD_DIM ** -0.5), v.reshape(shp)
    if rope is not None:
        q, k = apply_rope(q, *rope), apply_rope(k, *rope)
    q, k, v = (t.astype(F32).transpose(0, 2, 1, 3) for t in (q, k, v))
    lg_f = jax.nn.log_sigmoid(decay_f.astype(F32))
    lg_b = jax.nn.log_sigmoid(decay_b.astype(F32))
    o_f, st_f = retention_scan(q, k, v, lg_f, s0_f)
    o_b, st_b = retention_scan(q[:, :, ::-1], k[:, :, ::-1], v[:, :, ::-1], lg_b, s0_b)
    o = (o_f + o_b[:, :, ::-1]).transpose(0, 2, 1, 3)
    mu = jnp.mean(o, axis=-1, keepdims=True)
    var = jnp.mean(jnp.square(o - mu), axis=-1, keepdims=True)
    o = ((o - mu) * lax.rsqrt(var + EPS)).reshape(b, n, RET_W) * norm_g.astype(F32)
    return (jax.nn.silu(gate.astype(F32)) * o).astype(gate.dtype), st_f, st_b


def window_attention(q, k, v, kc, vc, sink):
    b, n, _, d = q.shape
    nb = n // BLOCK
    scale = d ** -0.5
    pad = ((0, 0), (BLOCK, BLOCK), (0, 0), (0, 0))
    kp, vp = jnp.pad(k, pad), jnp.pad(v, pad)
    kpos = jnp.arange(3 * BLOCK) - BLOCK
    band = jnp.abs(kpos[None, :] - jnp.arange(BLOCK)[:, None]) <= WINDOW
    sink_l = jnp.broadcast_to(sink.astype(F32).reshape(ATT_KV_HEADS, ATT_GROUP)[None, :, :, None, None],
                              (b, ATT_KV_HEADS, ATT_GROUP, BLOCK, 1))

    def one_block(i):
        start = i * BLOCK
        qi = lax.dynamic_slice_in_dim(q, start, BLOCK, 1).reshape(b, BLOCK, ATT_KV_HEADS, ATT_GROUP, d)
        ki = lax.dynamic_slice_in_dim(kp, start, 3 * BLOCK, 1)
        vi = lax.dynamic_slice_in_dim(vp, start, 3 * BLOCK, 1)
        absk = start + kpos
        valid = band & ((absk >= 0) & (absk < n))[None, :]
        s_loc = jnp.einsum('bqhgd,bkhd->bhgqk', qi, ki).astype(F32) * scale
        s_loc = jnp.where(valid, s_loc, -jnp.inf)
        s_ctx = jnp.einsum('bqhgd,bchd->bhgqc', qi, kc).astype(F32) * scale
        p = jax.nn.softmax(jnp.concatenate([s_loc, s_ctx, sink_l], axis=-1), axis=-1).astype(v.dtype)
        return (jnp.einsum('bhgqk,bkhd->bqhgd', p[..., :3 * BLOCK], vi)
                + jnp.einsum('bhgqc,bchd->bqhgd', p[..., 3 * BLOCK:-1], vc))

    out = lax.map(one_block, jnp.arange(nb))
    return jnp.moveaxis(out, 0, 1).reshape(b, n, ATT_W)


def context_attention(q, k, v, sink):
    b, m, _, d = q.shape
    qg = q.reshape(b, m, ATT_KV_HEADS, ATT_GROUP, d)
    s = jnp.einsum('bqhgd,bkhd->bhgqk', qg, k).astype(F32) * (d ** -0.5)
    sink_l = jnp.broadcast_to(sink.astype(F32).reshape(ATT_KV_HEADS, ATT_GROUP)[None, :, :, None, None],
                              (b, ATT_KV_HEADS, ATT_GROUP, m, 1))
    p = jax.nn.softmax(jnp.concatenate([s, sink_l], axis=-1), axis=-1)[..., :-1].astype(v.dtype)
    return jnp.einsum('bhgqk,bkhd->bqhgd', p, v).reshape(b, m, ATT_W)


def chunk_gating(u, v, norm_g, w_s, b_s):
    b, n, w = u.shape
    u = jax.nn.gelu(u.astype(F32))
    vg = jax.nn.gelu(v.astype(F32)).reshape(b, n // CHUNK, CHUNK, CM_GROUPS, CM_CH)
    mu = jnp.mean(vg, axis=-1, keepdims=True)
    var = jnp.mean(jnp.square(vg - mu), axis=-1, keepdims=True)
    vn = (vg - mu) * lax.rsqrt(var + EPS) * norm_g.astype(F32).reshape(CM_GROUPS, CM_CH)
    s = jnp.einsum('gpq,bcqgd->bcpgd', w_s.astype(F32), vn) + b_s.astype(F32).T[:, :, None]
    return (u * s.reshape(b, n, w)).astype(v.dtype)


def swiglu(z, wg, wu, wd):
    return (jax.nn.silu(z @ wg) * (z @ wu)) @ wd


def setup_inputs(seed: int = 0) -> dict:
    key = jax.random.key(seed)
    ks = jax.random.split(key, 22)
    nrm = lambda k, shape, s: jax.random.normal(k, shape, F32) * s
    base_logit = jnp.log(jnp.exp2(5.0 + jnp.arange(RET_HEADS, dtype=F32)) - 1.0)
    return {
        'x': nrm(ks[0], (BATCH, SEQ, D_MODEL), 1.0),
        'c': nrm(ks[1], (BATCH, D_MODEL), 1.0),
        'ctx': nrm(ks[2], (BATCH, CTX_LEN, D_MODEL), 1.0),
        'c_ctx': nrm(ks[3], (D_MODEL,), 1.0),
        'w_mod': nrm(ks[4], (DEPTH, D_MODEL, 6 * D_MODEL), 0.5 * D_MODEL ** -0.5),
        'b_mod': nrm(ks[5], (DEPTH, 6 * D_MODEL), 0.02),
        'norm1_g': 1.0 + nrm(ks[6], (DEPTH, D_MODEL), 0.02),
        'norm2_g': 1.0 + nrm(ks[7], (DEPTH, D_MODEL), 0.02),
        'w_in': nrm(ks[8], (DEPTH, D_MODEL, IN_W), D_MODEL ** -0.5),
        'ret_decay_f': base_logit + nrm(ks[9], (DEPTH, RET_HEADS), 0.1),
        'ret_decay_b': base_logit + nrm(ks[10], (DEPTH, RET_HEADS), 0.1),
        'ret_norm_g': 1.0 + nrm(ks[11], (DEPTH, RET_W), 0.02),
        'attn_sink': nrm(ks[12], (DEPTH, ATT_Q_HEADS), 0.5),
        'cm_norm_g': 1.0 + nrm(ks[13], (DEPTH, CM_W), 0.02),
        'cm_w_s': nrm(ks[14], (DEPTH, CM_GROUPS, CHUNK, CHUNK), CHUNK ** -0.5),
        'cm_b_s': 1.0 + nrm(ks[15], (DEPTH, CM_GROUPS, CHUNK), 0.1),
        'w_out': nrm(ks[16], (DEPTH, MIX_W, D_MODEL), MIX_W ** -0.5),
        'w_gate': nrm(ks[17], (DEPTH, D_MODEL, FFN_HID), D_MODEL ** -0.5),
        'w_up': nrm(ks[18], (DEPTH, D_MODEL, FFN_HID), D_MODEL ** -0.5),
        'w_down': nrm(ks[19], (DEPTH, FFN_HID, D_MODEL), FFN_HID ** -0.5),
        'final_norm_g': 1.0 + nrm(ks[20], (D_MODEL,), 0.02),
    }


def reference(x, c, ctx, c_ctx, w_mod, b_mod, norm1_g, norm2_g, w_in, ret_decay_f, ret_decay_b,
              ret_norm_g, attn_sink, cm_norm_g, cm_w_s, cm_b_s, w_out, w_gate, w_up, w_down, final_norm_g):
    bsz, n, _ = x.shape
    m = ctx.shape[1]
    rope = axial_rope_tables(n)
    silu_c = jax.nn.silu(c)[:, None, :]
    silu_cc = jax.nn.silu(c_ctx)
    zero_state = jnp.zeros((bsz, RET_HEADS, HEAD_DIM, HEAD_DIM), F32)
    h = ctx
    for l in range(DEPTH):
        last = l == DEPTH - 1
        mx = jnp.split(silu_c @ w_mod[l] + b_mod[l], 6, axis=-1)
        mc = jnp.split(silu_cc @ w_mod[l] + b_mod[l], 6, axis=-1)

        zx = modulate(rms_norm(x, norm1_g[l]), mx[0], mx[1])
        zc = modulate(rms_norm(h, norm1_g[l]), mc[0], mc[1])
        rq, rk, rv, rg, aq, ak, av, cu, cv = split_in(zx @ w_in[l])
        crq, crk, crv, crg, caq, cak, cav, ccu, ccv = split_in(zc @ w_in[l])

        ret_c, st_f, st_b = retention_mixer(crq, crk, crv, crg, ret_decay_f[l], ret_decay_b[l], ret_norm_g[l],
                                            zero_state, zero_state, None)
        ret_x, _, _ = retention_mixer(rq, rk, rv, rg, ret_decay_f[l], ret_decay_b[l], ret_norm_g[l],
                                      st_f, st_b, rope)

        ck = cak.reshape(bsz, m, ATT_KV_HEADS, HEAD_DIM)
        cvv = cav.reshape(bsz, m, ATT_KV_HEADS, HEAD_DIM)
        q = apply_rope(aq.reshape(bsz, n, ATT_Q_HEADS, HEAD_DIM), *rope)
        k = apply_rope(ak.reshape(bsz, n, ATT_KV_HEADS, HEAD_DIM), *rope)
        att_x = window_attention(q, k, av.reshape(bsz, n, ATT_KV_HEADS, HEAD_DIM), ck, cvv, attn_sink[l])

        cm_x = chunk_gating(cu, cv, cm_norm_g[l], cm_w_s[l], cm_b_s[l])

        x = x + mx[2] * (jnp.concatenate([ret_x, att_x, cm_x], axis=-1) @ w_out[l])
        x = x + mx[5] * swiglu(modulate(rms_norm(x, norm2_g[l]), mx[3], mx[4]), w_gate[l], w_up[l], w_down[l])

        if not last:
            att_c = context_attention(caq.reshape(bsz, m, ATT_Q_HEADS, HEAD_DIM), ck, cvv, attn_sink[l])
            cm_c = chunk_gating(ccu, ccv, cm_norm_g[l], cm_w_s[l], cm_b_s[l])
            h = h + mc[2] * (jnp.concatenate([ret_c, att_c, cm_c], axis=-1) @ w_out[l])
            h = h + mc[5] * swiglu(modulate(rms_norm(h, norm2_g[l]), mc[3], mc[4]), w_gate[l], w_up[l], w_down[l])
    return rms_norm(x, final_norm_g)
```

```cpp
#include <hip/hip_runtime.h>
#include <hip/hip_cooperative_groups.h>
#include <cstdio>
#include <cstdint>
namespace cg = cooperative_groups;
namespace pg8 {
#define PG8_LAS __attribute__((address_space(3)))
typedef unsigned short bf16_t;
typedef short bf16x8 __attribute__((ext_vector_type(8)));
typedef float f32x4 __attribute__((ext_vector_type(4)));
typedef unsigned u32x4 __attribute__((ext_vector_type(4)));
constexpr int BM = 256, BK = 64, HALF = 128, HTB = HALF * BK * 2  , STAGE_BYTES = 8 * HTB, NXCD = 8, WGM = 8;

__host__ __device__ __forceinline__ int lds_byte(int r, int c) { const int st = (r >> 4) * 2 + (c >> 5), rr = r & 15, cc = c & 31, ob = rr * 64 + cc * 2; return st * 1024 + (ob ^ (((ob >> 9) & 1) << 5)); }
__host__ __device__ __forceinline__ void stage_rc(int b, int& R, int& C) { const int st = b / 1024, sb = b % 1024, swz = sb ^ (((sb >> 9) & 1) << 5); R = (st >> 1) * 16 + swz / 64; C = (st & 1) * 32 + (swz % 64) / 2; }
__host__ __device__ __forceinline__ int perm32(int rho) { const int n = rho >> 4, i = rho & 15; return 8 * (i >> 2) + 4 * n + (i & 3); }

struct Unit { int pm, pn; };
struct Gemm { const bf16_t* A; const bf16_t* Bt; int M, N, K; };

struct StaticOrder {
    int nM, nN, nwg, G, c;
    __host__ __device__ void init(int M, int N, int G_, int c_) { nM = M / BM; nN = N / BM; nwg = nM * nN; G = G_; c = c_; }
    __host__ __device__ bool next(int i, Unit& u) const {
        const long L = (long)i * G + c; if (L >= nwg) return false;
        int wgid = (int)L; { const int q = nwg / NXCD, r = nwg % NXCD, xcd = wgid % NXCD, off = wgid / NXCD; wgid = (xcd < r ? xcd * (q + 1) : r * (q + 1) + (xcd - r) * q) + off; }
        const int nig = WGM * nN, gid = wgid / nig, fm = gid * WGM, gsz = (nM - fm) < WGM ? (nM - fm) : WGM;
        u.pm = fm + ((wgid % nig) % gsz); u.pn = (wgid % nig) / gsz; return true;
    }
    __device__ __forceinline__ void a_ready(const Unit&) const {}
    __device__ __forceinline__ void done(const Unit&) const {}
};
__device__ __forceinline__ unsigned cvt_pk_bf16(float lo, float hi) { unsigned r; asm volatile("v_cvt_pk_bf16_f32 %0, %1, %2" : "=v"(r) : "v"(lo), "v"(hi)); return r; }
typedef float f32x2 __attribute__((ext_vector_type(2)));
__device__ __forceinline__ float silu_f(float x) { return x * __builtin_amdgcn_rcpf(1.0f + __builtin_amdgcn_exp2f(-1.4426950408889634f * x)); }
__device__ __forceinline__ float gelu_tanh_f(float x) { return x * __builtin_amdgcn_rcpf(1.0f + __builtin_amdgcn_exp2f(-2.3022082f * (x + 0.044715f * x * x * x))); }

struct EpiIn {
    static constexpr bool PERM = true, AFTER_DRAIN = false;
    bf16_t* P; const float* rope;
    __device__ __forceinline__ void operator()(const f32x4 (&acc)[2][2][4][2], const Unit& u, int wr, int wc, int fr, int fq) const {
        const int pn = u.pn; const bool latent = u.pm < 128;
        const int row0 = u.pm * BM + wr * 64 + fr;
        const int half = wc & 1;
        const bool roped = latent && (pn < 2 || (pn >= 4 && pn <= 6));
        float inv[4];
#pragma unroll
        for (int i = 0; i < 4; ++i) inv[i] = exp2f(-(float)(4 * fq + i) * (13.287712379549449f / 16.0f));
#pragma unroll
        for (int ai = 0; ai < 2; ++ai)
#pragma unroll
            for (int m = 0; m < 4; ++m) {
                const int row = row0 + ai * HALF + m * 16;
                const int t = row & 16383; const int pos = half ? (t & 63) : (t >> 6);
                bf16_t* rowp = P + (size_t)row * 2304 + pn * BM + wc * 32 + 8 * fq;
                f32x4 cs0 = (f32x4){1.f, 0.f, 1.f, 0.f}, cs1 = cs0;
                if (roped) { const float p = (float)pos; const float a0 = p * inv[0], a1 = p * inv[1], a2 = p * inv[2], a3 = p * inv[3];
                    cs0 = (f32x4){__cosf(a0), __sinf(a0), __cosf(a1), __sinf(a1)}; cs1 = (f32x4){__cosf(a2), __sinf(a2), __cosf(a3), __sinf(a3)}; }
#pragma unroll
                for (int bj = 0; bj < 2; ++bj) {
                    f32x4 v0 = acc[ai][bj][m][0], v1 = acc[ai][bj][m][1];
                    int kind = 0; float sc = 1.f;
                    if (pn == 0) kind = 1;
                    else if (pn == 1) { kind = 1; sc = 0.125f; }
                    else if (pn == 3) kind = 2;
                    else if (pn == 4 || pn == 5) { kind = 1; sc = 0.125f * 1.4426950408889634f; }
                    else if (pn == 6) kind = (bj == 0) ? 1 : 0;
                    else if (pn >= 7) kind = 3;
                    if (kind == 1) {
                        f32x4 a, b;
                        a[0] = v0[0] * cs0[0] - v0[1] * cs0[1]; a[1] = v0[1] * cs0[0] + v0[0] * cs0[1];
                        a[2] = v0[2] * cs0[2] - v0[3] * cs0[3]; a[3] = v0[3] * cs0[2] + v0[2] * cs0[3];
                        b[0] = v1[0] * cs1[0] - v1[1] * cs1[1]; b[1] = v1[1] * cs1[0] + v1[0] * cs1[1];
                        b[2] = v1[2] * cs1[2] - v1[3] * cs1[3]; b[3] = v1[3] * cs1[2] + v1[2] * cs1[3];
                        v0 = a * sc; v1 = b * sc;
                    } else if (kind == 2) {
#pragma unroll
                        for (int j = 0; j < 4; ++j) { v0[j] = silu_f(v0[j]); v1[j] = silu_f(v1[j]); }
                    } else if (kind == 3) {
#pragma unroll
                        for (int j = 0; j < 4; ++j) { v0[j] = gelu_tanh_f(v0[j]); v1[j] = gelu_tanh_f(v1[j]); }
                    }
                    u32x4 w; w.x = cvt_pk_bf16(v0[0], v0[1]); w.y = cvt_pk_bf16(v0[2], v0[3]); w.z = cvt_pk_bf16(v1[0], v1[1]); w.w = cvt_pk_bf16(v1[2], v1[3]);
                    *(u32x4*)(rowp + bj * HALF) = w;
                }
            }
    }
};
struct EpiRes {
    static constexpr bool PERM = true, AFTER_DRAIN = false;
    float* X; const float* Xsrc; const float* gate0; float sgn;
    __device__ __forceinline__ void operator()(const f32x4 (&acc)[2][2][4][2], const Unit& u, int wr, int wc, int fr, int fq) const {
        const int s = u.pm < 64 ? 0 : (u.pm < 128 ? 1 : 2);
        const float* gv = gate0 + s * 6144;
        const int row0 = u.pm * BM + wr * 64 + fr, col0 = u.pn * BM + wc * 32 + 8 * fq;
        f32x4 g[2][2];
#pragma unroll
        for (int bj = 0; bj < 2; ++bj)
#pragma unroll
            for (int n = 0; n < 2; ++n) g[bj][n] = *(const f32x4*)(gv + col0 + bj * HALF + n * 4) * sgn;
#pragma unroll
        for (int ai = 0; ai < 2; ++ai)
#pragma unroll
            for (int mp = 0; mp < 2; ++mp) {
                f32x4 xv[2][2][2];
#pragma unroll
                for (int mm = 0; mm < 2; ++mm) { const float* rowp = Xsrc + (size_t)(row0 + ai * HALF + (2 * mp + mm) * 16) * 1024 + col0;
#pragma unroll
                    for (int bj = 0; bj < 2; ++bj)
#pragma unroll
                        for (int n = 0; n < 2; ++n) xv[mm][bj][n] = *(const f32x4*)(rowp + bj * HALF + n * 4); }
#pragma unroll
                for (int mm = 0; mm < 2; ++mm) { float* rowp = X + (size_t)(row0 + ai * HALF + (2 * mp + mm) * 16) * 1024 + col0;
#pragma unroll
                    for (int bj = 0; bj < 2; ++bj)
#pragma unroll
                        for (int n = 0; n < 2; ++n) *(f32x4*)(rowp + bj * HALF + n * 4) = xv[mm][bj][n] + g[bj][n] * acc[ai][bj][2 * mp + mm][n]; }
                asm volatile("" ::: "memory");
            }
    }
};
struct EpiGU {
    static constexpr bool PERM = true, AFTER_DRAIN = false;
    bf16_t* H;
    __device__ __forceinline__ void operator()(const f32x4 (&acc)[2][2][4][2], const Unit& u, int wr, int wc, int fr, int fq) const {
        const int row0 = u.pm * BM + wr * 64 + fr, hid0 = u.pn * HALF + wc * 32 + 8 * fq;
#pragma unroll
        for (int ai = 0; ai < 2; ++ai)
#pragma unroll
            for (int m = 0; m < 4; ++m) { bf16_t* rowp = H + (size_t)(row0 + ai * HALF + m * 16) * 2816 + hid0;
                f32x4 g0 = acc[ai][0][m][0], g1 = acc[ai][0][m][1]; const f32x4 u0 = acc[ai][1][m][0], u1 = acc[ai][1][m][1];
#pragma unroll
                for (int j = 0; j < 4; ++j) { g0[j] = silu_f(g0[j]) * u0[j]; g1[j] = silu_f(g1[j]) * u1[j]; }
                u32x4 w; w.x = cvt_pk_bf16(g0[0], g0[1]); w.y = cvt_pk_bf16(g0[2], g0[3]); w.z = cvt_pk_bf16(g1[0], g1[1]); w.w = cvt_pk_bf16(g1[2], g1[3]);
                *(u32x4*)rowp = w; }
    }
};

struct EpiAll {
    static constexpr bool AFTER_DRAIN = false;
    int mode; bool perm, align; EpiIn ein; EpiRes eres; EpiGU egu;
    __device__ __forceinline__ void operator()(const f32x4 (&acc)[2][2][4][2], const Unit& u, int wr, int wc, int fr, int fq) const {
        if (mode == 0) ein(acc, u, wr, wc, fr, fq); else if (mode == 1) eres(acc, u, wr, wc, fr, fq); else egu(acc, u, wr, wc, fr, fq);
    }
};

template <class Epi, class Sched, bool ALIGN_EPI = false, bool SP2 = false>
__device__ __forceinline__ void gemm_phase(PG8_LAS unsigned char* lds, const Gemm g, const Sched& S, const Epi& E) {
    int tid_o = threadIdx.x; asm volatile("" : "+v"(tid_o));
    const int tid = tid_o, wid = __builtin_amdgcn_readfirstlane(tid >> 6), lane = tid & 63, wr = wid >> 2, wc = wid & 3, fr = lane & 15, fq = lane >> 4;
    const int K = g.K, nt = K / BK;
    unsigned voffA[2], voffB[2];
#pragma unroll
    for (int i = 0; i < 2; ++i) { int R, C; stage_rc(tid * 16 + i * 8192, R, C); const int Rb = E.perm ? ((R & ~31) + perm32(R & 31)) : R;
        voffA[i] = (unsigned)(R * K + C) * 2u; voffB[i] = (unsigned)(Rb * K + C) * 2u; }
    const size_t kstep = (size_t)(BK * 2);
    const size_t hstep = (size_t)HALF * K * 2;
    const size_t tstep = 2 * hstep;
    const unsigned ldsw = (unsigned)wid * 1024u;
    const int aoff = lds_byte(wr * 64 + fr, fq * 8), boff = lds_byte(wc * 32 + fr, fq * 8);
#define PG8_SA(b, h) (((b) * 2 + (h)) * HTB)
#define PG8_SB(b, h) ((4 + (b) * 2 + (h)) * HTB)
#define PG8_STAGE(bufoff, gbase, voff) do { _Pragma("unroll") for (int _i = 0; _i < 2; ++_i) \
        __builtin_amdgcn_global_load_lds((const unsigned*)((const char*)(gbase) + (voff)[_i]), (PG8_LAS unsigned*)(lds + (bufoff) + ldsw + _i * 8192), 16, 0, 0); } while (0)
#define PG8_LDA(dst, b, h) do { _Pragma("unroll") for (int m = 0; m < 4; ++m) _Pragma("unroll") for (int k = 0; k < 2; ++k) dst[m][k] = *(const PG8_LAS bf16x8*)(lds + PG8_SA(b, h) + aoff + m * 2048 + k * 1024); } while (0)
#define PG8_LDB(dst, b, h) do { _Pragma("unroll") for (int n = 0; n < 2; ++n) _Pragma("unroll") for (int k = 0; k < 2; ++k) dst[n][k] = *(const PG8_LAS bf16x8*)(lds + PG8_SB(b, h) + boff + n * 2048 + k * 1024); } while (0)
#define PG8_MMA(ai, bj, At, Bt) do { __builtin_amdgcn_s_setprio(1); _Pragma("unroll") for (int m = 0; m < 4; ++m) _Pragma("unroll") for (int n = 0; n < 2; ++n) _Pragma("unroll") for (int k = 0; k < 2; ++k) \
        acc[ai][bj][m][n] = __builtin_amdgcn_mfma_f32_16x16x32_bf16(Bt[n][k], At[m][k], acc[ai][bj][m][n], 0, 0, 0); __builtin_amdgcn_s_setprio(0); } while (0)
#define PG8_WAIT_V(n) asm volatile("s_waitcnt vmcnt(" #n ")" ::: "memory")
#define PG8_WAIT_L(n) asm volatile("s_waitcnt lgkmcnt(" #n ")" ::: "memory")
#define PG8_BAR __builtin_amdgcn_s_barrier()
#define PG8_SCHED __builtin_amdgcn_sched_barrier(0)
    Unit cur, nxt; int ui = 0;
    if (!S.next(0, cur)) return;
    f32x4 acc[2][2][4][2];
#pragma unroll
    for (int a = 0; a < 2; ++a)
#pragma unroll
        for (int b = 0; b < 2; ++b)
#pragma unroll
            for (int m = 0; m < 4; ++m)
#pragma unroll
                for (int n = 0; n < 2; ++n) acc[a][b][m][n] = (f32x4){0.f, 0.f, 0.f, 0.f};
    bf16x8 At[4][2], B0[2][2], B1[2][2];
    const char* cA = (const char*)g.A + (size_t)cur.pm * tstep; const char* cB = (const char*)g.Bt + (size_t)cur.pn * tstep;
    S.a_ready(cur);
    if constexpr (SP2) {
        PG8_STAGE(PG8_SB(0, 0), cB, voffB); PG8_STAGE(PG8_SB(0, 1), cB + hstep, voffB); PG8_STAGE(PG8_SA(0, 0), cA, voffA); PG8_STAGE(PG8_SA(0, 1), cA + hstep, voffA);
        if (wr == 1) PG8_BAR;
        PG8_WAIT_V(2); PG8_BAR;
        PG8_STAGE(PG8_SB(1, 0), cB + kstep, voffB); PG8_STAGE(PG8_SA(1, 0), cA + kstep, voffA); PG8_STAGE(PG8_SB(1, 1), cB + hstep + kstep, voffB);
        PG8_WAIT_V(6); PG8_BAR;
    } else {
        PG8_STAGE(PG8_SB(0, 0), cB, voffB); PG8_STAGE(PG8_SA(0, 0), cA, voffA); PG8_STAGE(PG8_SB(0, 1), cB + hstep, voffB); PG8_STAGE(PG8_SA(0, 1), cA + hstep, voffA);
        if (wr == 1) PG8_BAR;
        PG8_WAIT_V(4); PG8_BAR;
        PG8_STAGE(PG8_SB(1, 0), cB + kstep, voffB); PG8_STAGE(PG8_SA(1, 0), cA + kstep, voffA); PG8_STAGE(PG8_SB(1, 1), cB + hstep + kstep, voffB);
        PG8_WAIT_V(6); PG8_BAR;
    }
    for (;;) {
        const bool has_next = S.next(ui + 1, nxt);
        const char* nA = has_next ? (const char*)g.A + (size_t)nxt.pm * tstep : cA; const char* nB = has_next ? (const char*)g.Bt + (size_t)nxt.pn * tstep : cB;
        for (int t = 0; t < nt; t += 2) {
            const bool last = (t == nt - 2);
            const char* a1 = cA + (size_t)(t + 1) * kstep;
            const char* a2 = last ? nA : cA + (size_t)(t + 2) * kstep; const char* b2 = last ? nB : cB + (size_t)(t + 2) * kstep;
            const char* a3 = a2 + kstep; const char* b3 = b2 + kstep;
            if (last && has_next) S.a_ready(nxt);
            if constexpr (SP2) {
            PG8_LDB(B0, 0, 0); PG8_LDB(B1, 0, 1); PG8_SCHED; PG8_LDA(At, 0, 0); PG8_STAGE(PG8_SA(1, 1), a1 + hstep, voffA);
            PG8_WAIT_V(8); PG8_WAIT_L(0); PG8_BAR; PG8_MMA(0, 0, At, B0); PG8_MMA(0, 1, At, B1); PG8_BAR; PG8_SCHED;
            PG8_LDA(At, 0, 1); PG8_STAGE(PG8_SB(0, 0), b2, voffB); PG8_STAGE(PG8_SB(0, 1), b2 + hstep, voffB); PG8_STAGE(PG8_SA(0, 0), a2, voffA);
            PG8_WAIT_V(8); PG8_WAIT_L(0); PG8_BAR; PG8_MMA(1, 0, At, B0); PG8_MMA(1, 1, At, B1); PG8_BAR; PG8_SCHED;
            PG8_LDB(B0, 1, 0); PG8_LDB(B1, 1, 1); PG8_SCHED; PG8_LDA(At, 1, 0); PG8_STAGE(PG8_SA(0, 1), a2 + hstep, voffA);
            PG8_WAIT_V(8); PG8_WAIT_L(0); PG8_BAR; PG8_MMA(0, 0, At, B0); PG8_MMA(0, 1, At, B1); PG8_BAR; PG8_SCHED;
            PG8_LDA(At, 1, 1); PG8_STAGE(PG8_SB(1, 0), b3, voffB); PG8_STAGE(PG8_SB(1, 1), b3 + hstep, voffB); PG8_STAGE(PG8_SA(1, 0), a3, voffA);
            PG8_WAIT_V(8); PG8_WAIT_L(0); PG8_BAR; PG8_MMA(1, 0, At, B0); PG8_MMA(1, 1, At, B1); PG8_BAR; PG8_SCHED;
            } else {
            PG8_LDB(B0, 0, 0); PG8_SCHED; PG8_LDA(At, 0, 0); PG8_STAGE(PG8_SA(1, 1), a1 + hstep, voffA);
            PG8_WAIT_L(8); PG8_BAR; PG8_WAIT_L(0); PG8_MMA(0, 0, At, B0); PG8_BAR; PG8_SCHED;
            PG8_LDB(B1, 0, 1); PG8_STAGE(PG8_SB(0, 0), b2, voffB);
            PG8_BAR; PG8_WAIT_L(0); PG8_MMA(0, 1, At, B1); PG8_BAR;
            PG8_LDA(At, 0, 1); PG8_STAGE(PG8_SA(0, 0), a2, voffA);
            PG8_BAR; PG8_WAIT_L(0); PG8_MMA(1, 0, At, B0); PG8_BAR; PG8_SCHED;
            PG8_STAGE(PG8_SB(0, 1), b2 + hstep, voffB);
            PG8_WAIT_V(6); PG8_BAR; PG8_MMA(1, 1, At, B1); PG8_BAR;
            PG8_LDB(B0, 1, 0); PG8_SCHED; PG8_LDA(At, 1, 0); PG8_STAGE(PG8_SA(0, 1), a2 + hstep, voffA);
            PG8_WAIT_L(8); PG8_BAR; PG8_WAIT_L(0); PG8_MMA(0, 0, At, B0); PG8_BAR; PG8_SCHED;
            PG8_LDB(B1, 1, 1); PG8_STAGE(PG8_SB(1, 0), b3, voffB);
            PG8_BAR; PG8_WAIT_L(0); PG8_MMA(0, 1, At, B1); PG8_BAR;
            PG8_LDA(At, 1, 1); PG8_STAGE(PG8_SA(1, 0), a3, voffA);
            PG8_BAR; PG8_WAIT_L(0); PG8_MMA(1, 0, At, B0); PG8_BAR; PG8_SCHED;
            PG8_STAGE(PG8_SB(1, 1), b3 + hstep, voffB);
            PG8_WAIT_V(6); PG8_BAR; PG8_MMA(1, 1, At, B1); PG8_BAR;
            }
        }
        if (E.align) { if (wr == 0) PG8_BAR; }
        if constexpr (!Epi::AFTER_DRAIN) { E(acc, cur, wr, wc, fr, fq); S.done(cur); }
        if (!has_next) break;
#pragma unroll
        for (int a = 0; a < 2; ++a)
#pragma unroll
            for (int b = 0; b < 2; ++b)
#pragma unroll
                for (int m = 0; m < 4; ++m)
#pragma unroll
                    for (int n = 0; n < 2; ++n) acc[a][b][m][n] = (f32x4){0.f, 0.f, 0.f, 0.f};
        cur = nxt; cA = nA; cB = nB; ++ui;
        if (E.align) { if (wr == 1) PG8_BAR; }
    }
    PG8_WAIT_V(0);
    if (!E.align) { if (wr == 0) PG8_BAR; }
    PG8_BAR;
    if constexpr (Epi::AFTER_DRAIN) { E.fused(acc, cur, wr, wc, fr, fq, lds, wid, lane); S.done(cur); }
#undef PG8_SA
#undef PG8_SB
#undef PG8_STAGE
#undef PG8_LDA
#undef PG8_LDB
#undef PG8_MMA
#undef PG8_WAIT_V
#undef PG8_WAIT_L
#undef PG8_BAR
#undef PG8_SCHED
}
}

#define LAS __attribute__((address_space(3)))
typedef unsigned short bf16;
typedef float f32x4 __attribute__((ext_vector_type(4)));
typedef unsigned u32x4v __attribute__((ext_vector_type(4)));
typedef unsigned u32x2v __attribute__((ext_vector_type(2)));
constexpr int NWAVES = 8, NT = 512;
constexpr int DM = 1024, SEQ = 16384, R_LAT = 32768, R_CTX = 512, R_ALL = 33280, INW = 2304, FF = 2816, GUW = 5632, DEPTH = 4;
constexpr int C_RQ = 0, C_RK = 256, C_RV = 512, C_RG = 768, C_AQ = 1024, C_AK = 1536, C_AV = 1664, C_CU = 1792, C_CV = 2048;
constexpr int NCHUNK = 260;
constexpr float LOG2E = 1.4426950408889634f;
constexpr float EPS = 1e-6f;
constexpr size_t MiB = 1u << 20;
constexpr size_t WS_BAR = 0, BAR_ZERO_BYTES = 16384;
constexpr size_t WS_MOD = 1 * MiB;
constexpr size_t WS_ROPE = WS_MOD + 512 * 1024;
constexpr size_t WS_DEC = WS_MOD + 768 * 1024;
constexpr size_t WS_W0 = 2 * MiB, WBUF_BYTES = 24 * MiB;
constexpr size_t WO_IN = 0, WO_OUT = (size_t)INW * DM * 2, WO_GU = WO_OUT + (size_t)DM * DM * 2, WO_DN = WO_GU + (size_t)GUW * DM * 2, WO_WS = WO_DN + (size_t)DM * FF * 2, WO_END = WO_WS + 4 * 128 * 128 * 2;
static_assert(WO_END <= WBUF_BYTES, "weight buffer");
constexpr size_t WS_X = WS_W0 + 2 * WBUF_BYTES;
constexpr size_t WS_ZM = WS_X + 130 * MiB;
constexpr size_t WS_PH = WS_ZM + 65 * MiB;
constexpr size_t WS_D = WS_PH + 179 * MiB;
constexpr size_t WS_S = WS_D + 33 * MiB;
constexpr size_t WS_END = WS_S + 17 * MiB;
static_assert((size_t)R_ALL * DM * 4 <= 130 * MiB && (size_t)R_ALL * DM * 2 <= 65 * MiB && (size_t)R_ALL * FF * 2 <= 179 * MiB && (size_t)NCHUNK * 8 * 4096 * 4 <= 33 * MiB, "ws map");
constexpr int LDS_BYTES = 147456;

struct Args {
    const float *x, *c, *ctx, *c_ctx, *w_mod, *b_mod, *norm1_g, *norm2_g, *w_in, *ret_decay_f, *ret_decay_b, *ret_norm_g, *attn_sink, *cm_norm_g, *cm_w_s, *cm_b_s, *w_out, *w_gate, *w_up, *w_down, *final_norm_g;
    float* out; unsigned char* ws; int ph_lo, ph_hi, rep_mask, sync_rep;
};

typedef const __attribute__((address_space(4))) Args* KArgs;

__device__ __forceinline__ float bf_lo(unsigned w) { return __uint_as_float(w << 16); }
__device__ __forceinline__ float bf_hi(unsigned w) { return __uint_as_float(w & 0xffff0000u); }
__device__ __forceinline__ unsigned f2bf(float f) { unsigned u = __float_as_uint(f); return (u + 0x7fffu + ((u >> 16) & 1u)) >> 16; }
__device__ __forceinline__ unsigned pk2(float lo, float hi) { return pg8::cvt_pk_bf16(lo, hi); }
__device__ __forceinline__ float wave_sum(float v) {
#pragma unroll
    for (int o = 1; o < 64; o <<= 1) v += __shfl_xor(v, o);
    return v;
}
__device__ __forceinline__ float log_sigmoid_f(float x) { return -log1pf(expf(-x)); }
#define UNPACK8(dst, off, PW) do { dst[(off) + 0] = bf_lo((PW)[0]); dst[(off) + 1] = bf_hi((PW)[0]); dst[(off) + 2] = bf_lo((PW)[1]); dst[(off) + 3] = bf_hi((PW)[1]); \
    dst[(off) + 4] = bf_lo((PW)[2]); dst[(off) + 5] = bf_hi((PW)[2]); dst[(off) + 6] = bf_lo((PW)[3]); dst[(off) + 7] = bf_hi((PW)[3]); } while (0)

template <int MAP> __device__ __forceinline__ int map_col(int n) {
    if (MAP == 1) { const bool qk = (n < 512) || (n >= 1024 && n < 1664); if (!qk) return n; const int d = n & 63, hf = d >> 5, w = d & 31, j = w & 15, sec = w >> 4; return (n & ~63) + hf * 32 + 2 * j + sec; }
    if (MAP == 2) return 256 * (n >> 7) + (n & 127);
    if (MAP == 3) return 256 * (n >> 7) + 128 + (n & 127);
    return n;
}
template <int MAP> __device__ __forceinline__ void transpose_item(const float* W, int K, int N, bf16* WT, LAS float* scr, int item, int lane) {
    const int nblk = N / 32, kb = item / nblk, nb = item % nblk, k0 = 64 * kb, n0 = 32 * nb;
#pragma unroll 8
    for (int i = 0; i < 32; ++i) { const int kk = 2 * i + (lane >> 5); scr[kk * 33 + (lane & 31)] = W[(size_t)(k0 + kk) * N + n0 + (lane & 31)]; }
    asm volatile("s_waitcnt lgkmcnt(0)" ::: "memory");
    const int c = lane & 7;
#pragma unroll
    for (int j = 0; j < 4; ++j) { const int n = (lane >> 3) + 8 * j; const LAS float* s = scr + (8 * c) * 33 + n;
        u32x4v o; o.x = pk2(s[0 * 33], s[1 * 33]); o.y = pk2(s[2 * 33], s[3 * 33]); o.z = pk2(s[4 * 33], s[5 * 33]); o.w = pk2(s[6 * 33], s[7 * 33]);
        *(u32x4v*)(WT + (size_t)map_col<MAP>(n0 + n) * K + k0 + 8 * c) = o; }
    asm volatile("s_waitcnt lgkmcnt(0)" ::: "memory");
}
__device__ __forceinline__ void convert_weights(KArgs a, int l, unsigned char* wb, LAS unsigned char* lds, int gw, int ngw, int wave, int lane) {
    LAS float* scr = (LAS float*)(lds + wave * 16384);
    constexpr int I_IN = 16 * 72, I_OUT = 16 * 32, I_G = 16 * 88, I_D = 44 * 32, I_WS = 16;
    constexpr int NIT = I_IN + I_OUT + 2 * I_G + I_D + I_WS;
    for (int it = gw; it < NIT; it += ngw) {
        int r = it;
        if (r < I_IN) { transpose_item<1>(a->w_in + (size_t)l * DM * INW, DM, INW, (bf16*)(wb + WO_IN), scr, r, lane); continue; } r -= I_IN;
        if (r < I_OUT) { transpose_item<0>(a->w_out + (size_t)l * DM * DM, DM, DM, (bf16*)(wb + WO_OUT), scr, r, lane); continue; } r -= I_OUT;
        if (r < I_G) { transpose_item<2>(a->w_gate + (size_t)l * DM * FF, DM, FF, (bf16*)(wb + WO_GU), scr, r, lane); continue; } r -= I_G;
        if (r < I_G) { transpose_item<3>(a->w_up + (size_t)l * DM * FF, DM, FF, (bf16*)(wb + WO_GU), scr, r, lane); continue; } r -= I_G;
        if (r < I_D) { transpose_item<0>(a->w_down + (size_t)l * FF * DM, FF, DM, (bf16*)(wb + WO_DN), scr, r, lane); continue; } r -= I_D;
        { const float* src = a->cm_w_s + (size_t)l * 65536 + r * 4096; bf16* dst = (bf16*)(wb + WO_WS) + r * 4096;
            for (int i = lane; i < 1024; i += 64) { const f32x4 v = *(const f32x4*)(src + 4 * i); u32x2v o; o.x = pk2(v[0], v[1]); o.y = pk2(v[2], v[3]); *(u32x2v*)(dst + 4 * i) = o; } }
    }
}
__device__ __forceinline__ void mod_phase(KArgs a, float* MOD, LAS unsigned char* lds, int bid, int G, int tid) {
    LAS float* sc = (LAS float*)lds;
    LAS float* red = (LAS float*)(lds + 16384);
    for (int i = tid; i < 3072; i += NT) { const float v = i < 2048 ? a->c[i] : a->c_ctx[i - 2048]; sc[i] = v / (1.0f + __expf(-v)); }
    __syncthreads();
    const int cx = tid & 31, ks = tid >> 5;
    for (int it = bid; it < 4 * 48; it += G) {
        const int l = it / 48, cb = it % 48;
        const float* W = a->w_mod + (size_t)l * DM * 6144 + cb * 128 + cx * 4;
        f32x4 a0 = {0.f, 0.f, 0.f, 0.f}, a1 = a0, a2 = a0;
#pragma unroll 4
        for (int k = ks * 64; k < ks * 64 + 64; ++k) { const f32x4 w = *(const f32x4*)(W + (size_t)k * 6144); a0 += w * sc[k]; a1 += w * sc[1024 + k]; a2 += w * sc[2048 + k]; }
        *(LAS f32x4*)(red + (ks * 3 + 0) * 128 + cx * 4) = a0; *(LAS f32x4*)(red + (ks * 3 + 1) * 128 + cx * 4) = a1; *(LAS f32x4*)(red + (ks * 3 + 2) * 128 + cx * 4) = a2;
        __syncthreads();
        if (tid < 384) { const int s = tid >> 7, col = tid & 127; float v = a->b_mod[l * 6144 + cb * 128 + col];
#pragma unroll
            for (int k = 0; k < 16; ++k) v += red[(k * 3 + s) * 128 + col];
            MOD[(size_t)(l * 3 + s) * 6144 + cb * 128 + col] = v; }
        __syncthreads();
    }
}
template <int MODE> __device__ __forceinline__ void norm_phase(KArgs a, float* XRES, bf16* ZN, const float* gvec, const float* mod_shift  , int nrows, int gw, int ngw, int lane) {
    f32x4 gm[4], hs[4]; int scur = -1;
#define NIDX(j) (2 * lane + 128 * ((j) >> 1) + ((j) & 1))
    if (MODE == 2) {
#pragma unroll
        for (int j = 0; j < 4; ++j) gm[j] = *((const f32x4*)gvec + NIDX(j)); }
    for (int ri = gw; ri < nrows; ri += ngw) {
        const int row = (ri < R_LAT && ngw == 2048) ? 4096 * ((ri >> 3) & 7) + (((ri >> 6) & 31) * 8 + (ri & 7)) + 256 * (ri >> 11) : ri;
        const float* src = (MODE == 1) ? (row < R_LAT ? a->x + (size_t)row * DM : a->ctx + (size_t)(row - R_LAT) * DM) : XRES + (size_t)row * DM;
        const f32x4* xr = (const f32x4*)src;
        f32x4 v[4]; float ss = 0.f;
#pragma unroll
        for (int j = 0; j < 4; ++j) { v[j] = xr[NIDX(j)]; ss += (v[j][0] * v[j][0] + v[j][1] * v[j][1]) + (v[j][2] * v[j][2] + v[j][3] * v[j][3]); }
        if (MODE != 2) { const int s = row < SEQ ? 0 : (row < R_LAT ? 1 : 2);
            if (s != scur) { scur = s; const float* sh = mod_shift + s * 6144; const float* scl = sh + 1024;
#pragma unroll
                for (int j = 0; j < 4; ++j) { gm[j] = *((const f32x4*)gvec + NIDX(j)) * (*((const f32x4*)scl + NIDX(j)) + 1.0f); hs[j] = *((const f32x4*)sh + NIDX(j)); } } }
        const float rstd = __builtin_amdgcn_rsqf(wave_sum(ss) * (1.0f / DM) + EPS);
        if (MODE == 2) { f32x4* o = (f32x4*)(a->out + (size_t)row * DM);
#pragma unroll
            for (int j = 0; j < 4; ++j) o[NIDX(j)] = v[j] * rstd * gm[j]; }
        else { u32x4v* o = (u32x4v*)(ZN + (size_t)row * DM);
#pragma unroll
            for (int h = 0; h < 2; ++h) { const f32x4 z0 = v[2 * h] * rstd * gm[2 * h] + hs[2 * h], z1 = v[2 * h + 1] * rstd * gm[2 * h + 1] + hs[2 * h + 1];
                u32x4v w; w[0] = pk2(z0[0], z0[1]); w[1] = pk2(z0[2], z0[3]); w[2] = pk2(z1[0], z1[1]); w[3] = pk2(z1[2], z1[3]); o[lane + 64 * h] = w; } }
    }
#undef NIDX
}

__device__ __forceinline__ void attn_naive_item(int item, const bf16* P, bf16* MIX, const float* sink, int tid) {
    const int rb = item >> 1, hk = item & 1, g = tid >> 7, r = tid & 127, hq = hk * 4 + g, row = rb * 128 + r;
    float q[64], o[64];
    { const u32x4v* qp = (const u32x4v*)(P + (size_t)row * INW + C_AQ + hq * 64);
#pragma unroll
      for (int i = 0; i < 8; ++i) { const u32x4v w = qp[i]; UNPACK8(q, 8 * i, w); } }
#pragma unroll
    for (int d = 0; d < 64; ++d) o[d] = 0.f;
    float m = -1e30f, lsum = 0.f;
    for (int sg = 0; sg < 4; ++sg) {
        int krow0, nk, mode;
        if (rb < 256) { const int b = rb >> 7, i = rb & 127;
            if (sg == 0) { if (i == 0) continue; krow0 = (rb - 1) * 128; nk = 128; mode = 1; }
            else if (sg == 1) { krow0 = rb * 128; nk = 128; mode = 0; }
            else if (sg == 2) { if (i == 127) continue; krow0 = (rb + 1) * 128; nk = 128; mode = 2; }
            else { krow0 = R_LAT + b * 256; nk = 256; mode = 0; } }
        else { if (sg != 3) continue; const int b = (rb - 256) >> 1; krow0 = R_LAT + b * 256; nk = 256; mode = 0; }
        for (int c = 0; c < nk; ++c) {
            const u32x4v* kp = (const u32x4v*)(P + (size_t)(krow0 + c) * INW + C_AK + hk * 64);
            float s = 0.f;
#pragma unroll
            for (int i = 0; i < 8; ++i) { const u32x4v w = kp[i]; float kk[8]; UNPACK8(kk, 0, w);
#pragma unroll
                for (int e = 0; e < 8; ++e) s += q[8 * i + e] * kk[e]; }
            const bool valid = (mode == 0) || (mode == 1 ? (c >= r) : (c <= r));
            s = valid ? s : -INFINITY;
            const float mn = fmaxf(m, s), al = exp2f(m - mn), p = exp2f(s - mn);
            lsum = lsum * al + p; m = mn;
            const u32x4v* vp = (const u32x4v*)(P + (size_t)(krow0 + c) * INW + C_AV + hk * 64);
#pragma unroll
            for (int i = 0; i < 8; ++i) { const u32x4v w = vp[i]; float vv[8]; UNPACK8(vv, 0, w);
#pragma unroll
                for (int e = 0; e < 8; ++e) o[8 * i + e] = o[8 * i + e] * al + p * vv[e]; }
        }
    }
    { const float sl = sink[hq] * LOG2E, mf = fmaxf(m, sl), al = exp2f(m - mf); lsum = lsum * al + exp2f(sl - mf); const float inv = al / lsum;
      u32x4v* op = (u32x4v*)(MIX + (size_t)row * DM + 256 + hq * 64);
#pragma unroll
      for (int i = 0; i < 8; ++i) { u32x4v w; w.x = pk2(o[8 * i] * inv, o[8 * i + 1] * inv); w.y = pk2(o[8 * i + 2] * inv, o[8 * i + 3] * inv); w.z = pk2(o[8 * i + 4] * inv, o[8 * i + 5] * inv); w.w = pk2(o[8 * i + 6] * inv, o[8 * i + 7] * inv); op[i] = w; } }
}
__device__ __forceinline__ void gmlp_naive_item(int ch, const bf16* P, bf16* MIX, const float* norm_g, const float* w_s, const float* b_s, LAS unsigned char* lds, int tid) {
    LAS float* vn = (LAS float*)lds;
    const int g = tid >> 7, p = tid & 127, row = ch * 128 + p;
    { float v[64]; const u32x4v* vp = (const u32x4v*)(P + (size_t)row * INW + C_CV + g * 64);
#pragma unroll
      for (int i = 0; i < 8; ++i) { const u32x4v w = vp[i]; UNPACK8(v, 8 * i, w); }
      float s = 0.f;
#pragma unroll
      for (int d = 0; d < 64; ++d) s += v[d];
      const float mu = s * (1.0f / 64.0f); float qq = 0.f;
#pragma unroll
      for (int d = 0; d < 64; ++d) { v[d] -= mu; qq += v[d] * v[d]; }
      const float rstd = 1.0f / sqrtf(qq * (1.0f / 64.0f) + EPS);
#pragma unroll
      for (int d = 0; d < 64; ++d) vn[p * 256 + g * 64 + d] = v[d] * rstd * norm_g[g * 64 + d]; }
    __syncthreads();
    float acc[64];
#pragma unroll
    for (int d = 0; d < 64; ++d) acc[d] = 0.f;
    const float* wrow = w_s + (size_t)(g * 128 + p) * 128;
    for (int qi = 0; qi < 128; ++qi) { const float w = wrow[qi]; const LAS f32x4* vr = (const LAS f32x4*)(vn + qi * 256 + g * 64);
#pragma unroll
        for (int i = 0; i < 16; ++i) { const f32x4 x = vr[i]; acc[4 * i] += w * x[0]; acc[4 * i + 1] += w * x[1]; acc[4 * i + 2] += w * x[2]; acc[4 * i + 3] += w * x[3]; } }
    const float bs = b_s[g * 128 + p];
    const u32x4v* up = (const u32x4v*)(P + (size_t)row * INW + C_CU + g * 64); u32x4v* op = (u32x4v*)(MIX + (size_t)row * DM + 768 + g * 64);
#pragma unroll
    for (int i = 0; i < 8; ++i) { const u32x4v w = up[i]; float uu[8]; UNPACK8(uu, 0, w);
#pragma unroll
        for (int e = 0; e < 8; ++e) uu[e] *= (acc[8 * i + e] + bs);
        u32x4v o; o.x = pk2(uu[0], uu[1]); o.y = pk2(uu[2], uu[3]); o.z = pk2(uu[4], uu[5]); o.w = pk2(uu[6], uu[7]); op[i] = o; }
    __syncthreads();
}
__device__ __forceinline__ void retd_naive_item(int item, const bf16* P, float* DB, float l2f, float l2b, LAS unsigned char* lds, int tid) {
    const int ch = item >> 2, h = item & 3;
    LAS float* Ks = (LAS float*)lds; LAS float* Vs = Ks + 8192; LAS float* wf = Vs + 8192; LAS float* wb = wf + 128;
    for (int i = tid; i < 1024; i += NT) { const int j = i >> 3, c8 = (i & 7) * 8; const size_t ro = (size_t)(ch * 128 + j) * INW + h * 64 + c8;
        const u32x4v kw = *(const u32x4v*)(P + ro + C_RK), vw = *(const u32x4v*)(P + ro + C_RV); float t[8];
        UNPACK8(t, 0, kw);
#pragma unroll
        for (int e = 0; e < 8; ++e) Ks[j * 64 + c8 + e] = t[e];
        UNPACK8(t, 0, vw);
#pragma unroll
        for (int e = 0; e < 8; ++e) Vs[j * 64 + c8 + e] = t[e]; }
    if (tid < 128) { wf[tid] = exp2f((float)(127 - tid) * l2f); wb[tid] = exp2f((float)tid * l2b); }
    __syncthreads();
    float* Df = DB + (size_t)(item * 2) * 4096; float* Dbk = Df + 4096;
#pragma unroll 1
    for (int i = 0; i < 8; ++i) { const int e = tid + NT * i, dv = e >> 6, dk = e & 63; float af = 0.f, ab = 0.f;
        for (int j = 0; j < 128; ++j) { const float kv = Ks[j * 64 + dk] * Vs[j * 64 + dv]; af += wf[j] * kv; ab += wb[j] * kv; }
        Df[e] = af; Dbk[e] = ab; }
    __syncthreads();
}
__device__ __forceinline__ void scan_phase(const float* __restrict__ DB, bf16* __restrict__ SB, const float* decay_f, const float* decay_b, int gtid, int gthreads) {
    for (int id = gtid; id < 65536; id += gthreads) {
        const int e = id & 4095, dir = (id >> 12) & 1, h = (id >> 13) & 3, b = id >> 15;
        const float cd = exp2f(128.0f * (dir ? decay_b[h] : decay_f[h]));
        const size_t off = (size_t)(h * 2 + dir) * 4096 + e;
        const int c0 = 256 + 2 * b, c1 = c0 + 1;
        const int first = dir ? c1 : c0, second = dir ? c0 : c1;
        const float d0 = DB[(size_t)first * 32768 + off], d1 = DB[(size_t)second * 32768 + off];
        float s = d0;
        SB[(size_t)first * 32768 + off] = (bf16)0;
        SB[(size_t)second * 32768 + off] = (bf16)f2bf(s); s = s * cd + d1;
#pragma unroll 1
        for (int i0 = 0; i0 < 128; i0 += 32) {
            float d[32];
#pragma unroll
            for (int i = 0; i < 32; ++i) { const int ch = b * 128 + (dir ? 127 - (i0 + i) : (i0 + i)); d[i] = DB[(size_t)ch * 32768 + off]; }
#pragma unroll
            for (int i = 0; i < 32; ++i) { const int ch = b * 128 + (dir ? 127 - (i0 + i) : (i0 + i)); SB[(size_t)ch * 32768 + off] = (bf16)f2bf(s); s = s * cd + d[i]; }
        }
    }
}
__device__ __forceinline__ void reto_naive_item(int item, const bf16* P, const bf16* SB, bf16* MIX, const float* norm_g, float l2f, float l2b, int tid) {
    const int ch = item >> 2, h = item & 3, r = tid >> 2, qt = tid & 3, row = ch * 128 + r;
    float q[64], o[16];
    { const u32x4v* qp = (const u32x4v*)(P + (size_t)row * INW + C_RQ + h * 64);
#pragma unroll
      for (int i = 0; i < 8; ++i) { const u32x4v w = qp[i]; UNPACK8(q, 8 * i, w); } }
#pragma unroll
    for (int d = 0; d < 16; ++d) o[d] = 0.f;
    for (int j = 0; j < 128; ++j) {
        const u32x4v* kp = (const u32x4v*)(P + (size_t)(ch * 128 + j) * INW + C_RK + h * 64);
        float s = 0.f;
#pragma unroll
        for (int i = 0; i < 8; ++i) { const u32x4v w = kp[i]; float kk[8]; UNPACK8(kk, 0, w);
#pragma unroll
            for (int e = 0; e < 8; ++e) s += q[8 * i + e] * kk[e]; }
        const float w = (r > j) ? exp2f((float)(r - j) * l2f) : ((r < j) ? exp2f((float)(j - r) * l2b) : 2.0f);
        s *= w;
        const u32x4v* vp = (const u32x4v*)(P + (size_t)(ch * 128 + j) * INW + C_RV + h * 64 + qt * 16);
#pragma unroll
        for (int i = 0; i < 2; ++i) { const u32x4v vw = vp[i]; float vv[8]; UNPACK8(vv, 0, vw);
#pragma unroll
            for (int e = 0; e < 8; ++e) o[8 * i + e] += s * vv[e]; }
    }
    { const float qdf = exp2f((float)(r + 1) * l2f), qdb = exp2f((float)(128 - r) * l2b);
      const bf16* Sf = SB + (size_t)(item * 2) * 4096; const bf16* Sb = Sf + 4096;
#pragma unroll 1
      for (int d = 0; d < 16; ++d) { const int dv = qt * 16 + d; const u32x4v* fp = (const u32x4v*)(Sf + dv * 64); const u32x4v* bp = (const u32x4v*)(Sb + dv * 64); float tf = 0.f, tb = 0.f;
#pragma unroll
          for (int i = 0; i < 8; ++i) { const u32x4v wf = fp[i], wb = bp[i]; float ff[8], bb[8]; UNPACK8(ff, 0, wf); UNPACK8(bb, 0, wb);
#pragma unroll
              for (int e = 0; e < 8; ++e) { tf += q[8 * i + e] * ff[e]; tb += q[8 * i + e] * bb[e]; } }
          const float t = qdf * tf + qdb * tb;
#pragma unroll
          for (int dd = 0; dd < 16; ++dd) o[dd] += (dd == d) ? t : 0.f; } }
    float s = 0.f;
#pragma unroll
    for (int d = 0; d < 16; ++d) s += o[d];
    s += __shfl_xor(s, 1); s += __shfl_xor(s, 2);
    const float mu = s * (1.0f / 64.0f); float qq = 0.f;
#pragma unroll
    for (int d = 0; d < 16; ++d) { o[d] -= mu; qq += o[d] * o[d]; }
    qq += __shfl_xor(qq, 1); qq += __shfl_xor(qq, 2);
    const float rstd = 1.0f / sqrtf(qq * (1.0f / 64.0f) + EPS);
    const u32x4v* gp = (const u32x4v*)(P + (size_t)row * INW + C_RG + h * 64 + qt * 16); u32x4v* op = (u32x4v*)(MIX + (size_t)row * DM + h * 64 + qt * 16);
#pragma unroll
    for (int i = 0; i < 2; ++i) { const u32x4v gw = gp[i]; float gg[8]; UNPACK8(gg, 0, gw);
#pragma unroll
        for (int e = 0; e < 8; ++e) gg[e] *= o[8 * i + e] * rstd * norm_g[h * 64 + qt * 16 + 8 * i + e];
        u32x4v w; w.x = pk2(gg[0], gg[1]); w.y = pk2(gg[2], gg[3]); w.z = pk2(gg[4], gg[5]); w.w = pk2(gg[6], gg[7]); op[i] = w; }
}

typedef short bf16x8 __attribute__((ext_vector_type(8)));
typedef short s16x4 __attribute__((ext_vector_type(4)));
__device__ __forceinline__ s16x4 tr16(LAS const unsigned char* p) { return __builtin_bit_cast(s16x4, __builtin_amdgcn_ds_read_tr16_b64_v4i16((LAS s16x4*)p)); }
__device__ __forceinline__ bf16x8 cat8(s16x4 a, s16x4 b) { return (bf16x8){a[0], a[1], a[2], a[3], b[0], b[1], b[2], b[3]}; }
__device__ __forceinline__ bf16x8 pack8(f32x4 a, f32x4 b) { u32x4v w; w[0] = pg8::cvt_pk_bf16(a[0], a[1]); w[1] = pg8::cvt_pk_bf16(a[2], a[3]); w[2] = pg8::cvt_pk_bf16(b[0], b[1]); w[3] = pg8::cvt_pk_bf16(b[2], b[3]); return __builtin_bit_cast(bf16x8, w); }
__device__ __forceinline__ float rows4_max(float x) {
    auto r = __builtin_amdgcn_permlane16_swap(__float_as_uint(x), __float_as_uint(x), false, false); x = fmaxf(__uint_as_float(r[0]), __uint_as_float(r[1]));
    auto q = __builtin_amdgcn_permlane32_swap(__float_as_uint(x), __float_as_uint(x), false, false); return fmaxf(__uint_as_float(q[0]), __uint_as_float(q[1]));
}
__device__ __forceinline__ float rows4_sum(float x) {
    auto r = __builtin_amdgcn_permlane16_swap(__float_as_uint(x), __float_as_uint(x), false, false); x = __uint_as_float(r[0]) + __uint_as_float(r[1]);
    auto q = __builtin_amdgcn_permlane32_swap(__float_as_uint(x), __float_as_uint(x), false, false); return __uint_as_float(q[0]) + __uint_as_float(q[1]);
}
#define MFMA16(a, b, c) __builtin_amdgcn_mfma_f32_16x16x32_bf16(a, b, c, 0, 0, 0)
#define EXP2(x) __builtin_amdgcn_exp2f(x)
constexpr int KVS = 144;
constexpr int KVT = 128 * KVS;
#ifndef PFD
#define PFD 3
#endif

__device__ __forceinline__ void attn_mfma_item(int item, const bf16* P, bf16* MIX, const float* sink, LAS unsigned char* lds, int tid) {
    const int lane = tid & 63, wave = __builtin_amdgcn_readfirstlane(tid >> 6), g = wave >> 1, r0w = 64 * (item & 1) + 32 * (wave & 1);
    const int rb = item >> 2, hk = (item >> 1) & 1, hq = hk * 4 + g, l15 = lane & 15, lg = lane >> 4, q4 = (lane & 15) >> 2, p4 = lane & 3;
    const bool lat = rb < 256; const int bi = rb & 127;
    const int ng = lat ? 5 - (bi == 0 ? 1 : 0) - (bi == 127 ? 1 : 0) : 2;
    const int ctx0 = R_LAT + (lat ? (rb >> 7) : ((rb - 256) >> 1)) * 256;
    bf16x8 qf[2][2];
#pragma unroll
    for (int qt = 0; qt < 2; ++qt)
#pragma unroll
        for (int ks = 0; ks < 2; ++ks) qf[qt][ks] = *(const bf16x8*)(P + (size_t)(rb * 128 + r0w + 16 * qt + l15) * INW + C_AQ + hq * 64 + 32 * ks + 8 * lg);
#pragma unroll
    for (int qt = 0; qt < 2; ++qt)
#pragma unroll
        for (int ks = 0; ks < 2; ++ks) asm volatile("" : "+v"(qf[qt][ks]));
    f32x4 o[4][2];
#pragma unroll
    for (int i = 0; i < 4; ++i)
#pragma unroll
        for (int j = 0; j < 2; ++j) o[i][j] = (f32x4){0.f, 0.f, 0.f, 0.f};
    float m[2]; f32x4 lacc[2];
#pragma unroll
    for (int i = 0; i < 2; ++i) { m[i] = 0.f; lacc[i] = (f32x4){0.f, 0.f, 0.f, 0.f}; }
    bool fresh = true;
    constexpr float DEFER = 8.0f;
    const bf16x8 ones = (bf16x8){0x3F80, 0x3F80, 0x3F80, 0x3F80, 0x3F80, 0x3F80, 0x3F80, 0x3F80};
    const int skey = tid >> 2, spart = tid & 3;
    u32x4v rs[PFD][4];
#define ATT_GID(k) ((lat) ? (((k) + (bi == 0 ? 1 : 0)) + ((bi == 127 && ((k) + (bi == 0 ? 1 : 0)) >= 2) ? 1 : 0)) : (3 + (k)))
#define ATT_ROW0(id) ((id) == 0 ? (rb - 1) * 128 : ((id) == 1 ? rb * 128 : ((id) == 2 ? (rb + 1) * 128 : ctx0 + ((id) - 3) * 128)))
#define ATT_LOAD(k, S) do { const int id_ = ATT_GID(k); const bf16* kp_ = P + (size_t)(ATT_ROW0(id_) + skey) * INW + C_AK + hk * 64 + spart * 16; \
        rs[S][0] = *(const u32x4v*)kp_; rs[S][1] = *(const u32x4v*)(kp_ + 8); rs[S][2] = *(const u32x4v*)(kp_ + (C_AV - C_AK)); rs[S][3] = *(const u32x4v*)(kp_ + (C_AV - C_AK) + 8); } while (0)
#pragma unroll
    for (int k = 0; k < PFD; ++k) if (k < ng) ATT_LOAD(k, k);
#pragma unroll
    for (int k = 0; k < 5; ++k) if (k < ng) {
        LAS unsigned char* Kb = lds + (k & 1) * 2 * KVT; LAS unsigned char* Vb = Kb + KVT;
        { LAS unsigned char* d = Kb + skey * KVS + spart * 32; *(LAS u32x4v*)d = rs[k % PFD][0]; *(LAS u32x4v*)(d + 16) = rs[k % PFD][1]; d += KVT; *(LAS u32x4v*)d = rs[k % PFD][2]; *(LAS u32x4v*)(d + 16) = rs[k % PFD][3]; }
        __syncthreads();
        const int id = ATT_GID(k); const int mode = (id == 0) ? 1 : ((id == 2) ? 2 : 0);
        if (k + PFD < ng) ATT_LOAD(k + PFD, k % PFD);
#pragma unroll 1
        for (int sub = 0; sub < 2; ++sub) {
            if ((mode == 1 && sub == 0 && (item & 1)) || (mode == 2 && sub == 1 && !(item & 1))) continue;
            f32x4 s[4][2];
#pragma unroll
            for (int kt = 0; kt < 4; ++kt) {
                const LAS unsigned char* kr = Kb + (64 * sub + 16 * kt + l15) * KVS + 16 * lg;
                const bf16x8 kf0 = *(const LAS bf16x8*)kr, kf1 = *(const LAS bf16x8*)(kr + 64);
#pragma unroll
                for (int qt = 0; qt < 2; ++qt) { s[kt][qt] = MFMA16(kf0, qf[qt][0], ((f32x4){-m[qt], -m[qt], -m[qt], -m[qt]})); s[kt][qt] = MFMA16(kf1, qf[qt][1], s[kt][qt]); }
            }
            if (mode != 0) {
                const int mb = 64 * sub + 4 * lg - l15 - r0w;
                if (mode == 1) {
#pragma unroll
                    for (int kt = 0; kt < 4; ++kt)
#pragma unroll
                        for (int qt = 0; qt < 2; ++qt)
#pragma unroll
                            for (int r = 0; r < 4; ++r) s[kt][qt][r] = (mb >= -(16 * kt + r - 16 * qt)) ? s[kt][qt][r] : -INFINITY;
                } else {
#pragma unroll
                    for (int kt = 0; kt < 4; ++kt)
#pragma unroll
                        for (int qt = 0; qt < 2; ++qt)
#pragma unroll
                            for (int r = 0; r < 4; ++r) s[kt][qt][r] = (mb <= -(16 * kt + r - 16 * qt)) ? s[kt][qt][r] : -INFINITY;
                }
            }
            float mxq[2];
#pragma unroll
            for (int qt = 0; qt < 2; ++qt) {
                float mx = fmaxf(fmaxf(s[0][qt][0], s[0][qt][1]), fmaxf(s[0][qt][2], s[0][qt][3]));
#pragma unroll
                for (int kt = 1; kt < 4; ++kt) mx = fmaxf(mx, fmaxf(fmaxf(s[kt][qt][0], s[kt][qt][1]), fmaxf(s[kt][qt][2], s[kt][qt][3])));
                mxq[qt] = rows4_max(mx);
            }
            if (fresh || __builtin_amdgcn_ballot_w64(mxq[0] > DEFER || mxq[1] > DEFER) != 0ull) {
#pragma unroll
                for (int qt = 0; qt < 2; ++qt) {
                    const float d = fresh ? fmaxf(mxq[qt], -1e30f) : (mxq[qt] > DEFER ? mxq[qt] : 0.f);
                    m[qt] += d;
                    if (!fresh) { const float al = EXP2(-d); lacc[qt] = lacc[qt] * al;
#pragma unroll
                        for (int dvt = 0; dvt < 4; ++dvt) o[dvt][qt] = o[dvt][qt] * al; }
#pragma unroll
                    for (int kt = 0; kt < 4; ++kt)
#pragma unroll
                        for (int r = 0; r < 4; ++r) s[kt][qt][r] = EXP2(s[kt][qt][r] - d);
                }
            } else {
#pragma unroll
                for (int qt = 0; qt < 2; ++qt)
#pragma unroll
                    for (int kt = 0; kt < 4; ++kt)
#pragma unroll
                        for (int r = 0; r < 4; ++r) s[kt][qt][r] = EXP2(s[kt][qt][r]);
            }
            fresh = false;
#pragma unroll
            for (int ks = 0; ks < 2; ++ks) {
                bf16x8 pf[2];
#pragma unroll
                for (int qt = 0; qt < 2; ++qt) { pf[qt] = pack8(s[2 * ks][qt], s[2 * ks + 1][qt]); lacc[qt] = MFMA16(ones, pf[qt], lacc[qt]); }
#pragma unroll
                for (int dvt = 0; dvt < 4; ++dvt) {
                    const LAS unsigned char* vr = Vb + (64 * sub + 32 * ks + 4 * lg + q4) * KVS + (16 * dvt + 4 * p4) * 2;
                    const bf16x8 vf = cat8(tr16(vr), tr16(vr + 16 * KVS));
#pragma unroll
                    for (int qt = 0; qt < 2; ++qt) o[dvt][qt] = MFMA16(vf, pf[qt], o[dvt][qt]);
                }
            }
        }
    }
#undef ATT_GID
#undef ATT_ROW0
#undef ATT_LOAD
    const float sl = sink[hq] * LOG2E;
#pragma unroll
    for (int qt = 0; qt < 2; ++qt) {
        const float mf = fmaxf(m[qt], sl), al = EXP2(m[qt] - mf), den = lacc[qt][0] * al + EXP2(sl - mf), sc = al / den;
        bf16* op = MIX + (size_t)(rb * 128 + r0w + 16 * qt + l15) * DM + 256 + hq * 64 + 4 * lg;
#pragma unroll
        for (int dvt = 0; dvt < 4; ++dvt) { const f32x4 v = o[dvt][qt] * sc; u32x2v w; w[0] = pg8::cvt_pk_bf16(v[0], v[1]); w[1] = pg8::cvt_pk_bf16(v[2], v[3]); *(u32x2v*)(op + 16 * dvt) = w; }
    }
    __syncthreads();
}

__device__ __forceinline__ void reto_mfma_phase(const bf16* P, const bf16* SB, bf16* MIX, const float* norm_g, const float* decay_f, const float* decay_b, int n_items, int bid, int G, LAS unsigned char* lds, int tid) {
    const int lane = tid & 63, wave = __builtin_amdgcn_readfirstlane(tid >> 6), l15 = lane & 15, lg = lane >> 4, q4 = (lane & 15) >> 2, p4 = lane & 3;
    const int skey = tid >> 2, spart = tid & 3;
    LAS unsigned char* Kb = lds; LAS unsigned char* Vb = lds + KVT;
    u32x4v rs[PFD][4];
#define RO_LOAD(it_, S) do { const bf16* kp_ = P + (size_t)(((it_) >> 2) * 128 + skey) * INW + C_RK + ((it_) & 3) * 64 + spart * 16; \
        rs[S][0] = *(const u32x4v*)kp_; rs[S][1] = *(const u32x4v*)(kp_ + 8); rs[S][2] = *(const u32x4v*)(kp_ + (C_RV - C_RK)); rs[S][3] = *(const u32x4v*)(kp_ + (C_RV - C_RK) + 8); } while (0)
#pragma unroll
    for (int j = 0; j < PFD; ++j) if (bid + j * G < n_items) RO_LOAD(bid + j * G, j);
#pragma unroll
    for (int j = 0; j < 5; ++j) { const int it = bid + j * G; if (it < n_items) {
        const int ch = it >> 2, h = it & 3, i = 16 * wave + l15; const size_t row = (size_t)ch * 128 + i;
        const float df = decay_f[h], db = decay_b[h];
        bf16x8 qf[2], sf[4][2], sb[4][2]; u32x2v gw[4]; f32x4 ng[4];
#pragma unroll
        for (int ks = 0; ks < 2; ++ks) qf[ks] = *(const bf16x8*)(P + row * INW + C_RQ + h * 64 + 32 * ks + 8 * lg);
        { const bf16* Sf = SB + (size_t)(it * 2) * 4096; const bf16* Sb = Sf + 4096;
#pragma unroll
          for (int dvt = 0; dvt < 4; ++dvt)
#pragma unroll
              for (int ks = 0; ks < 2; ++ks) { const int so = (16 * dvt + l15) * 64 + 32 * ks + 8 * lg; sf[dvt][ks] = *(const bf16x8*)(Sf + so); sb[dvt][ks] = *(const bf16x8*)(Sb + so); } }
#pragma unroll
        for (int dvt = 0; dvt < 4; ++dvt) { const int dv0 = h * 64 + 16 * dvt + 4 * lg; gw[dvt] = *(const u32x2v*)(P + row * INW + C_RG + dv0); ng[dvt] = *(const f32x4*)(norm_g + dv0); }
        { LAS unsigned char* d = Kb + skey * KVS + spart * 32; *(LAS u32x4v*)d = rs[j % PFD][0]; *(LAS u32x4v*)(d + 16) = rs[j % PFD][1]; d += KVT; *(LAS u32x4v*)d = rs[j % PFD][2]; *(LAS u32x4v*)(d + 16) = rs[j % PFD][3]; }
        __syncthreads();
        f32x4 o[4], tf[4], tb[4];
#pragma unroll
        for (int d = 0; d < 4; ++d) { o[d] = (f32x4){0.f, 0.f, 0.f, 0.f}; tf[d] = o[d]; tb[d] = o[d]; }
#pragma unroll
        for (int dvt = 0; dvt < 4; ++dvt)
#pragma unroll
            for (int ks = 0; ks < 2; ++ks) { tf[dvt] = MFMA16(sf[dvt][ks], qf[ks], tf[dvt]); tb[dvt] = MFMA16(sb[dvt][ks], qf[ks], tb[dvt]); }
#pragma unroll
        for (int d = 0; d < 4; ++d) asm volatile("" : "+v"(tf[d]), "+v"(tb[d]));
        if (it + PFD * G < n_items) RO_LOAD(it + PFD * G, j % PFD);
        const float l2f = df, l2b = db;
        f32x4 s[8];
#pragma unroll
        for (int jt = 0; jt < 8; ++jt) { const LAS unsigned char* kr = Kb + (16 * jt + l15) * KVS + 16 * lg;
            s[jt] = MFMA16(*(const LAS bf16x8*)kr, qf[0], ((f32x4){0.f, 0.f, 0.f, 0.f})); s[jt] = MFMA16(*(const LAS bf16x8*)(kr + 64), qf[1], s[jt]); }
#pragma unroll
        for (int jt = 0; jt < 8; ++jt)
#pragma unroll
            for (int r = 0; r < 4; ++r) { const int jj = 16 * jt + 4 * lg + r; const int dd = i - jj; const float e = EXP2((float)(dd < 0 ? -dd : dd) * (dd < 0 ? l2b : l2f)); s[jt][r] *= (dd == 0) ? 2.0f : e; }
#pragma unroll
        for (int ks = 0; ks < 4; ++ks) { const bf16x8 pf = pack8(s[2 * ks], s[2 * ks + 1]);
#pragma unroll
            for (int dvt = 0; dvt < 4; ++dvt) { const LAS unsigned char* vr = Vb + (32 * ks + 4 * lg + q4) * KVS + (16 * dvt + 4 * p4) * 2;
                o[dvt] = MFMA16(cat8(tr16(vr), tr16(vr + 16 * KVS)), pf, o[dvt]); } }
        const float qdf = EXP2((float)(i + 1) * l2f), qdb = EXP2((float)(128 - i) * l2b);
        float sum = 0.f;
#pragma unroll
        for (int d = 0; d < 4; ++d) { o[d] = o[d] + tf[d] * qdf + tb[d] * qdb; sum += (o[d][0] + o[d][1]) + (o[d][2] + o[d][3]); }
        sum = rows4_sum(sum);
        const float mu = sum * (1.0f / 64.0f); float qq = 0.f;
#pragma unroll
        for (int d = 0; d < 4; ++d) { o[d] = o[d] - mu; qq += (o[d][0] * o[d][0] + o[d][1] * o[d][1]) + (o[d][2] * o[d][2] + o[d][3] * o[d][3]); }
        qq = rows4_sum(qq);
        const float rstd = __builtin_amdgcn_rsqf(qq * (1.0f / 64.0f) + EPS);
#pragma unroll
        for (int dvt = 0; dvt < 4; ++dvt) { const int dv0 = h * 64 + 16 * dvt + 4 * lg;
            const f32x4 gt = (f32x4){bf_lo(gw[dvt][0]), bf_hi(gw[dvt][0]), bf_lo(gw[dvt][1]), bf_hi(gw[dvt][1])};
            const f32x4 v = o[dvt] * rstd * ng[dvt] * gt; u32x2v w; w[0] = pg8::cvt_pk_bf16(v[0], v[1]); w[1] = pg8::cvt_pk_bf16(v[2], v[3]);
            *(u32x2v*)(MIX + row * DM + dv0) = w; }
        __syncthreads();
    } }
#undef RO_LOAD
}

__device__ __forceinline__ void retd_mfma_phase(const bf16* P, float* DB, const float* decay_f, const float* decay_b, int it0, int n_items, int G, LAS unsigned char* lds, int tid) {
    const int lane = tid & 63, wave = __builtin_amdgcn_readfirstlane(tid >> 6), l15 = lane & 15, lg = lane >> 4, q4 = (lane & 15) >> 2, p4 = lane & 3;
    const int skey = tid >> 2, spart = tid & 3, dir = wave & 1, dvt = wave >> 1;
    u32x4v rk0, rk1, rv0, rv1;
#define RD_LOAD(it_) do { const bf16* kp_ = P + (size_t)(((it_) >> 2) * 128 + skey) * INW + C_RK + ((it_) & 3) * 64 + spart * 16; \
        rk0 = *(const u32x4v*)kp_; rk1 = *(const u32x4v*)(kp_ + 8); rv0 = *(const u32x4v*)(kp_ + (C_RV - C_RK)); rv1 = *(const u32x4v*)(kp_ + (C_RV - C_RK) + 8); } while (0)
    if (it0 < n_items) RD_LOAD(it0);
    for (int it = it0; it < n_items; it += G) {
        const int h = it & 3;
        const float l2f = decay_f[h], l2b = decay_b[h];
        { const float wf = EXP2((float)(127 - skey) * l2f), wb = EXP2((float)skey * l2b);
          float t[16]; UNPACK8(t, 0, rk0); UNPACK8(t, 8, rk1);
          u32x4v a0, a1, b0, b1;
#pragma unroll
          for (int e = 0; e < 4; ++e) { a0[e] = pg8::cvt_pk_bf16(t[2 * e] * wf, t[2 * e + 1] * wf); a1[e] = pg8::cvt_pk_bf16(t[8 + 2 * e] * wf, t[9 + 2 * e] * wf);
              b0[e] = pg8::cvt_pk_bf16(t[2 * e] * wb, t[2 * e + 1] * wb); b1[e] = pg8::cvt_pk_bf16(t[8 + 2 * e] * wb, t[9 + 2 * e] * wb); }
          LAS unsigned char* d = lds + skey * KVS + spart * 32; *(LAS u32x4v*)d = a0; *(LAS u32x4v*)(d + 16) = a1; d += KVT; *(LAS u32x4v*)d = b0; *(LAS u32x4v*)(d + 16) = b1;
          d += KVT; *(LAS u32x4v*)d = rv0; *(LAS u32x4v*)(d + 16) = rv1; }
        __syncthreads();
        if (it + G < n_items) RD_LOAD(it + G);
        f32x4 acc[4];
#pragma unroll
        for (int d = 0; d < 4; ++d) acc[d] = (f32x4){0.f, 0.f, 0.f, 0.f};
        const LAS unsigned char* Kt = lds + dir * KVT; const LAS unsigned char* Vt = lds + 2 * KVT;
#pragma unroll
        for (int ks = 0; ks < 4; ++ks) { const int ro = (32 * ks + 4 * lg + q4) * KVS + 8 * p4;
            const bf16x8 vf = cat8(tr16(Vt + ro + 32 * dvt), tr16(Vt + ro + 32 * dvt + 16 * KVS));
#pragma unroll
            for (int dkt = 0; dkt < 4; ++dkt) acc[dkt] = MFMA16(vf, cat8(tr16(Kt + ro + 32 * dkt), tr16(Kt + ro + 32 * dkt + 16 * KVS)), acc[dkt]); }
        float* Dp = DB + (size_t)(it * 2 + dir) * 4096 + (16 * dvt + 4 * lg) * 64 + l15;
#pragma unroll
        for (int dkt = 0; dkt < 4; ++dkt)
#pragma unroll
            for (int r = 0; r < 4; ++r) Dp[r * 64 + 16 * dkt] = acc[dkt][r];
        __syncthreads();
    }
#undef RD_LOAD
}

__device__ __forceinline__ void gmlp_mfma_item(int ch, const bf16* P, bf16* MIX, const float* norm_g, const bf16* WS, const float* b_s, LAS unsigned char* lds, int tid) {
    const int lane = tid & 63, wave = __builtin_amdgcn_readfirstlane(tid >> 6), l15 = lane & 15, lg = lane >> 4, q4 = (lane & 15) >> 2, p4 = lane & 3;
    const int gW = wave >> 1, p0W = 64 * (wave & 1);
    bf16x8 wfa[4][4];
#pragma unroll
    for (int ks = 0; ks < 4; ++ks)
#pragma unroll
        for (int pt = 0; pt < 4; ++pt) wfa[ks][pt] = *(const bf16x8*)(WS + (size_t)gW * 16384 + (size_t)(p0W + 16 * pt + l15) * 128 + 32 * ks + 8 * lg);
    { const int g = tid >> 7, q = tid & 127; float v[64]; const u32x4v* vp = (const u32x4v*)(P + (size_t)(ch * 128 + q) * INW + C_CV + g * 64);
#pragma unroll
      for (int i = 0; i < 8; ++i) { const u32x4v w = vp[i]; UNPACK8(v, 8 * i, w); }
      float s = 0.f;
#pragma unroll
      for (int d = 0; d < 64; ++d) s += v[d];
      const float mu = s * (1.0f / 64.0f); float qq = 0.f;
#pragma unroll
      for (int d = 0; d < 64; ++d) { v[d] -= mu; qq += v[d] * v[d]; }
      const float rstd = __builtin_amdgcn_rsqf(qq * (1.0f / 64.0f) + EPS);
      LAS unsigned char* dst = lds + g * KVT + q * KVS;
#pragma unroll
      for (int i = 0; i < 8; ++i) { const f32x4 n0 = *(const f32x4*)(norm_g + g * 64 + 8 * i), n1 = *(const f32x4*)(norm_g + g * 64 + 8 * i + 4); u32x4v w;
          w[0] = pg8::cvt_pk_bf16(v[8 * i] * rstd * n0[0], v[8 * i + 1] * rstd * n0[1]); w[1] = pg8::cvt_pk_bf16(v[8 * i + 2] * rstd * n0[2], v[8 * i + 3] * rstd * n0[3]);
          w[2] = pg8::cvt_pk_bf16(v[8 * i + 4] * rstd * n1[0], v[8 * i + 5] * rstd * n1[1]); w[3] = pg8::cvt_pk_bf16(v[8 * i + 6] * rstd * n1[2], v[8 * i + 7] * rstd * n1[3]);
          *(LAS u32x4v*)(dst + 16 * i) = w; } }
    __syncthreads();
    const int g = wave >> 1, p0 = 64 * (wave & 1);
    const LAS unsigned char* Vn = lds + g * KVT; const bf16* W = WS + (size_t)g * 16384;
    f32x4 acc[4][4];
#pragma unroll
    for (int i = 0; i < 4; ++i)
#pragma unroll
        for (int j = 0; j < 4; ++j) acc[i][j] = (f32x4){0.f, 0.f, 0.f, 0.f};
#pragma unroll
    for (int ks = 0; ks < 4; ++ks) {
        bf16x8 wf[4], vf[4];
#pragma unroll
        for (int pt = 0; pt < 4; ++pt) wf[pt] = wfa[ks][pt];
#pragma unroll
        for (int dt = 0; dt < 4; ++dt) { const LAS unsigned char* vr = Vn + (32 * ks + 8 * lg + q4) * KVS + (16 * dt + 4 * p4) * 2; vf[dt] = cat8(tr16(vr), tr16(vr + 4 * KVS)); }
#pragma unroll
        for (int dt = 0; dt < 4; ++dt)
#pragma unroll
            for (int pt = 0; pt < 4; ++pt) acc[dt][pt] = MFMA16(vf[dt], wf[pt], acc[dt][pt]);
    }
#pragma unroll
    for (int pt = 0; pt < 4; ++pt) { const int p = p0 + 16 * pt + l15; const size_t row = (size_t)ch * 128 + p; const float bs = b_s[g * 128 + p];
#pragma unroll
        for (int dt = 0; dt < 4; ++dt) { const int c0 = g * 64 + 16 * dt + 4 * lg; const u32x2v uw = *(const u32x2v*)(P + row * INW + C_CU + c0);
            const f32x4 uu = (f32x4){bf_lo(uw[0]), bf_hi(uw[0]), bf_lo(uw[1]), bf_hi(uw[1])}; const f32x4 v = uu * (acc[dt][pt] + bs);
            u32x2v w; w[0] = pg8::cvt_pk_bf16(v[0], v[1]); w[1] = pg8::cvt_pk_bf16(v[2], v[3]); *(u32x2v*)(MIX + row * DM + 768 + c0) = w; } }
    __syncthreads();
}

template <int MODE> __device__ __forceinline__ void ctx_gemm(const bf16* A  , int K, const bf16* Bt, float* X, const float* Xsrc, const float* gate, float sgn, bf16* H, int bid, int G, LAS unsigned char* lds, int tid) {
    const int lane = tid & 63, wave = __builtin_amdgcn_readfirstlane(tid >> 6), l15 = lane & 15, lg = lane >> 4;
    const int ntile = MODE == 0 ? 256 : 1408, ksz = K >> 3, nks = ksz >> 5;
    for (int tile = bid; tile < ntile; tile += G) {
        int row0, brow[4];
        if (MODE == 0) { row0 = (tile >> 4) * 32; const int n0 = (tile & 15) * 64;
#pragma unroll
            for (int ct = 0; ct < 4; ++ct) brow[ct] = n0 + 16 * ct + l15; }
        else { row0 = (tile / 88) * 32; const int hb = tile % 88, n0 = 256 * (hb >> 2) + 32 * (hb & 3);
#pragma unroll
            for (int ct = 0; ct < 4; ++ct) brow[ct] = n0 + 128 * (ct >> 1) + 16 * (ct & 1) + l15; }
        f32x4 acc[2][4];
#pragma unroll
        for (int i = 0; i < 2; ++i)
#pragma unroll
            for (int j = 0; j < 4; ++j) acc[i][j] = (f32x4){0.f, 0.f, 0.f, 0.f};
        const bf16* ap = A + (size_t)(row0 + l15) * K + wave * ksz + 8 * lg;
        const bf16* bp0 = Bt + (size_t)brow[0] * K + wave * ksz + 8 * lg; const bf16* bp1 = Bt + (size_t)brow[1] * K + wave * ksz + 8 * lg;
        const bf16* bp2 = Bt + (size_t)brow[2] * K + wave * ksz + 8 * lg; const bf16* bp3 = Bt + (size_t)brow[3] * K + wave * ksz + 8 * lg;
#pragma unroll 4
        for (int ks = 0; ks < nks; ++ks) {
            const bf16x8 a0 = *(const bf16x8*)(ap + 32 * ks), a1 = *(const bf16x8*)(ap + (size_t)16 * K + 32 * ks);
            const bf16x8 b0 = *(const bf16x8*)(bp0 + 32 * ks), b1 = *(const bf16x8*)(bp1 + 32 * ks), b2 = *(const bf16x8*)(bp2 + 32 * ks), b3 = *(const bf16x8*)(bp3 + 32 * ks);
            acc[0][0] = MFMA16(b0, a0, acc[0][0]); acc[0][1] = MFMA16(b1, a0, acc[0][1]); acc[0][2] = MFMA16(b2, a0, acc[0][2]); acc[0][3] = MFMA16(b3, a0, acc[0][3]);
            acc[1][0] = MFMA16(b0, a1, acc[1][0]); acc[1][1] = MFMA16(b1, a1, acc[1][1]); acc[1][2] = MFMA16(b2, a1, acc[1][2]); acc[1][3] = MFMA16(b3, a1, acc[1][3]);
        }
        LAS f32x4* red = (LAS f32x4*)lds;
#pragma unroll
        for (int rt = 0; rt < 2; ++rt)
#pragma unroll
            for (int ct = 0; ct < 4; ++ct) red[((wave * 2 + rt) * 4 + ct) * 64 + lane] = acc[rt][ct];
        __syncthreads();
        if (MODE == 0) {
            const int slot = tid >> 6, rt = slot >> 2, ct = slot & 3;
            f32x4 v = red[slot * 64 + lane];
#pragma unroll
            for (int w = 1; w < 8; ++w) v += red[(w * 8 + slot) * 64 + lane];
            const int row = row0 + 16 * rt + l15, col = (tile & 15) * 64 + 16 * ct + 4 * lg;
            f32x4* xp = (f32x4*)(X + (size_t)(R_LAT + row) * DM + col); *xp = *(const f32x4*)(Xsrc + (size_t)row * DM + col) + *(const f32x4*)(gate + col) * v * sgn;
        } else if (tid < 256) {
            const int slot = tid >> 6, rt = slot >> 1, cg = slot & 1;
            f32x4 gv = red[((rt * 4) + cg) * 64 + lane], uv = red[((rt * 4) + cg + 2) * 64 + lane];
#pragma unroll
            for (int w = 1; w < 8; ++w) { gv += red[((w * 2 + rt) * 4 + cg) * 64 + lane]; uv += red[((w * 2 + rt) * 4 + cg + 2) * 64 + lane]; }
            const int hb = tile % 88, row = row0 + 16 * rt + l15, hid = 32 * hb + 16 * cg + 4 * lg;
            f32x4 hv;
#pragma unroll
            for (int j = 0; j < 4; ++j) hv[j] = pg8::silu_f(gv[j]) * uv[j];
            u32x2v w; w[0] = pg8::cvt_pk_bf16(hv[0], hv[1]); w[1] = pg8::cvt_pk_bf16(hv[2], hv[3]);
            *(u32x2v*)(H + (size_t)(R_LAT + row) * FF + hid) = w;
        }
        __syncthreads();
    }
}

#define XB_TMO      128
#define XB_XCNT(j)  (256  + 64 * (j))
#define XB_XSUB(j)  (1280 + 64 * (j))
#define XB_XGEN(j)  (2304 + 64 * (j))
#define XB_TOP      3328
#define XB_TOPGEN   3392
#define XCD_BAR_WORDS 3456
#define XB_SPIN_CAP (1u << 18)

__device__ __forceinline__ unsigned xb_ld(unsigned* p)              { return __hip_atomic_load(p, __ATOMIC_RELAXED, __HIP_MEMORY_SCOPE_AGENT); }
__device__ __forceinline__ unsigned xb_add(unsigned* p, unsigned v) { return __hip_atomic_fetch_add(p, v, __ATOMIC_RELAXED, __HIP_MEMORY_SCOPE_AGENT); }
__device__ __forceinline__ unsigned xb_xcc_id() { return (unsigned)__builtin_amdgcn_s_getreg((3 << 11) | 20) & 0xFu; }
#define XB_SPIN(cond, bar) do { unsigned _sp = 0; while (cond) { __builtin_amdgcn_s_sleep(1); \
    if ((++_sp & 255u) == 0u) { if (xb_ld(&(bar)[XB_TMO])) break; if (_sp > XB_SPIN_CAP) { atomicAdd(&(bar)[XB_TMO], 1u); break; } } } } while (0)

struct XcdBarrier {
    unsigned* bar; unsigned x;
    volatile LAS unsigned* st;
};

__device__ __forceinline__ XcdBarrier xcd_barrier_post(unsigned* bar, volatile LAS unsigned* st) {
    XcdBarrier b; b.bar = bar; b.x = xb_xcc_id(); b.st = st;
    if (threadIdx.x == 0) (void)xb_add(&bar[XB_XCNT(b.x)], 1u);
    return b;
}
__device__ __forceinline__ void xcd_barrier_complete(unsigned* bar, unsigned x, unsigned& nloc, unsigned& nx) {
    const unsigned G = gridDim.x * gridDim.y * gridDim.z;
    unsigned sum, cnt, mine, sp = 0u;
    for (;;) {
        sum = 0u; cnt = 0u; mine = 0u;
#pragma unroll
        for (unsigned j = 0; j < 16; ++j) { const unsigned c = xb_ld(&bar[XB_XCNT(j)]); sum += c; cnt += (c > 0u) ? 1u : 0u; mine = (j == x) ? c : mine; }
        if (sum == G) break;
        __builtin_amdgcn_s_sleep(1);
        if ((++sp & 255u) == 0u) { if (xb_ld(&bar[XB_TMO])) break; if (sp > XB_SPIN_CAP) { atomicAdd(&bar[XB_TMO], 1u); break; } }
    }
    nloc = mine > 0u ? mine : 1u; nx = cnt > 0u ? cnt : 1u;
}

__device__ __forceinline__ void xcd_barrier(const XcdBarrier& b) {
    asm volatile("s_waitcnt vmcnt(0)" ::: "memory");
    __syncthreads();
    if (threadIdx.x == 0) {
        unsigned* bar = b.bar;
        __builtin_amdgcn_s_waitcnt(0);
        unsigned nloc = b.st[0], nx = b.st[1];
        if (nloc == 0u) { xcd_barrier_complete(bar, b.x, nloc, nx); b.st[0] = nloc; b.st[1] = nx; }
        const unsigned old = xb_add(&bar[XB_XSUB(b.x)], 1u);
        const unsigned gen = old / nloc;
        if (old + 1u == (gen + 1u) * nloc) {
            __builtin_amdgcn_fence(__ATOMIC_RELEASE, "agent");
            asm volatile("s_waitcnt vmcnt(0)" ::: "memory");
            const unsigned og = xb_add(&bar[XB_TOP], 1u);
            const unsigned tg = og / nx;
            if (og + 1u == (tg + 1u) * nx) xb_add(&bar[XB_TOPGEN], 1u);
            else XB_SPIN(xb_ld(&bar[XB_TOPGEN]) == tg, bar);
            __builtin_amdgcn_fence(__ATOMIC_ACQUIRE, "agent");
            xb_add(&bar[XB_XGEN(b.x)], 1u);
            asm volatile("s_waitcnt vmcnt(0)" ::: "memory");
        } else {
            XB_SPIN(xb_ld(&bar[XB_XGEN(b.x)]) == gen, bar);
            __builtin_amdgcn_fence(__ATOMIC_ACQUIRE, "agent");
            asm volatile("s_waitcnt vmcnt(0)" ::: "memory");
        }
    }
    __syncthreads();
}

#ifndef EPIRES_ALIGN
#define EPIRES_ALIGN true
#endif
#ifndef REP_MASK
#define REP_MASK 0
#endif
#ifndef SYNC_REP
#define SYNC_REP 1
#endif
#ifndef PHMASK
#define PHMASK 255
#endif
constexpr int N_PHASES = 2 + 9 * DEPTH;
__global__ void __launch_bounds__(NT, 2) fwd_kernel(Args a_unused) {
    extern __shared__ __attribute__((aligned(16))) unsigned char lds_raw[];
    LAS unsigned char* lds = (LAS unsigned char*)lds_raw;
    cg::grid_group grid = cg::this_grid();
    const int G = gridDim.x, bid = blockIdx.x, ngw = G * NWAVES;
    volatile LAS unsigned* MISC = (volatile LAS unsigned*)(lds + 131072);
    if (threadIdx.x < 64) MISC[threadIdx.x] = 0u;
    __syncthreads();
    XcdBarrier xbar = xcd_barrier_post((unsigned*)(a_unused.ws + WS_BAR), MISC + 8);
    const int ph_lo = a_unused.ph_lo, ph_hi = a_unused.ph_hi, rep_mask = a_unused.rep_mask, sync_rep = a_unused.sync_rep;
    int rep = 0;
    for (int ph = ph_lo; ph < ph_hi;) {
        KArgs a = (KArgs)__builtin_amdgcn_kernarg_segment_ptr(); asm volatile("" : "+s"(a));
        unsigned char* ws = a->ws;
        float* MOD = (float*)(ws + WS_MOD); float* ROPE = (float*)(ws + WS_ROPE);
        float* XRES = (float*)(ws + WS_X); bf16* ZM = (bf16*)(ws + WS_ZM); bf16* PH = (bf16*)(ws + WS_PH);
        float* DB = (float*)(ws + WS_D); bf16* SB = (bf16*)(ws + WS_S); float* DEC = (float*)(ws + WS_DEC);
        int tid = threadIdx.x; asm volatile("" : "+v"(tid));
        const int lane = tid & 63, wave = __builtin_amdgcn_readfirstlane(tid >> 6), gw = bid * NWAVES + wave;
        if (ph == 0) {
            for (int i = bid * NT + tid; i < 4096; i += G * NT) { const int pos = i >> 4, j = i & 15; const float inv = exp2f(-(float)j * (13.287712379549449f / 16.0f)); const float ang = (float)pos * inv;
                ROPE[2 * i] = __cosf(ang); ROPE[2 * i + 1] = __sinf(ang); }
            if (bid == 0 && tid < 32) { const int l_ = tid >> 3, d_ = (tid >> 2) & 1, h_ = tid & 3; DEC[tid] = log_sigmoid_f((d_ ? a->ret_decay_b : a->ret_decay_f)[l_ * 4 + h_]) * LOG2E; }
            mod_phase(a, MOD, lds, bid, G, tid);
            __syncthreads();
            convert_weights(a, 0, ws + WS_W0, lds, gw, ngw, wave, lane);
        } else if (ph == N_PHASES - 1) {
            norm_phase<2>(a, XRES, ZM, a->final_norm_g, MOD, R_LAT, gw, ngw, lane);
        } else {
            const int l = (ph - 1) / 9, k = (ph - 1) % 9; const bool last = (l == DEPTH - 1);
            unsigned char* wb = ws + WS_W0 + (size_t)(l & 1) * WBUF_BYTES;
            const float* modl = MOD + (size_t)l * 3 * 6144;
            const int rows_out = last ? R_LAT : R_ALL;
            if (k == 0) {
                if (l == 0) norm_phase<1>(a, XRES, ZM, a->norm1_g, modl, R_ALL, gw, ngw, lane);
                else norm_phase<0>(a, XRES, ZM, a->norm1_g + l * DM, modl, R_ALL, gw, ngw, lane);
            } else if (k == 1 || k == 5 || k == 7 || k == 8) {
                const int gm = (k == 1 || (k == 7 && !last)) ? R_ALL : R_LAT, gn = (k == 1) ? INW : (k == 7 ? GUW : DM), gk = (k == 8) ? FF : DM;
                const bf16* gA = (k == 8) ? PH : ZM;
                const bf16* gB = (const bf16*)(wb + (k == 1 ? WO_IN : (k == 5 ? WO_OUT : (k == 7 ? WO_GU : WO_DN))));
                pg8::Gemm g{gA, gB, gm, gn, gk}; pg8::StaticOrder S; S.init(gm, gn, G, bid);
                pg8::EpiAll E{(k == 1) ? 0 : (k == 7 ? 2 : 1), true, (k == 1 || k == 7) || EPIRES_ALIGN, pg8::EpiIn{PH, ROPE}, pg8::EpiRes{XRES, (l == 0 && k == 5) ? a->x : (const float*)XRES, modl + (k == 5 ? 2 * 1024 : 5 * 1024), (rep == 1) ? -1.0f : 1.0f}, pg8::EpiGU{PH}};
#if PHMASK & 1
                pg8::gemm_phase<pg8::EpiAll, pg8::StaticOrder, true, true>(lds, g, S, E);
#endif
                if (!last && (k == 5 || k == 8)) {
                    ctx_gemm<0>(gA + (size_t)R_LAT * gk, gk, gB, XRES, (l == 0 && k == 5) ? a->ctx : (const float*)(XRES + (size_t)R_LAT * DM), modl + 2 * 6144 + (k == 5 ? 2 * 1024 : 5 * 1024), (rep == 1) ? -1.0f : 1.0f, PH, bid, G, lds, tid);
                }
            } else if (k == 2) {
                const int n_att = last ? 1024 : 1040, n_cm = last ? 256 : 260, n_d = NCHUNK * 4;
                for (int rr = 0; rr < 1 + ((rep_mask >> 10) & 1); ++rr)
                for (int it = bid; it < n_att; it += G) attn_mfma_item(it, PH, ZM, a->attn_sink + l * 8, lds, tid);
                const int o1 = (G - (n_att % G)) % G;
                for (int rr = 0; rr < 1 + ((rep_mask >> 11) & 1); ++rr)
                for (int it = (bid + o1) % G; it < n_cm; it += G) gmlp_mfma_item(it, PH, ZM, a->cm_norm_g + l * 256, (const bf16*)(wb + WO_WS), a->cm_b_s + l * 512, lds, tid);
                const int o2 = (o1 + G - (n_cm % G)) % G;
                for (int rr = 0; rr < 1 + ((rep_mask >> 12) & 1); ++rr)
                retd_mfma_phase(PH, DB, DEC + l * 8, DEC + l * 8 + 4, (bid + o2) % G, n_d, G, lds, tid);
            } else if (k == 3) {
                scan_phase(DB, SB, DEC + l * 8, DEC + l * 8 + 4, bid * NT + tid, G * NT);
                if (!last) { const int w0 = (65536 / NT < G) ? (65536 / NT) * NWAVES : 0;
                    if (gw >= w0) convert_weights(a, l + 1, ws + WS_W0 + (size_t)((l + 1) & 1) * WBUF_BYTES, lds, gw - w0, ngw - w0, wave, lane); }
            } else if (k == 4) {
                reto_mfma_phase(PH, SB, ZM, a->ret_norm_g + l * 256, DEC + l * 8, DEC + l * 8 + 4, (last ? 256 : 260) * 4, bid, G, lds, tid);
            } else if (k == 6) {
                norm_phase<0>(a, XRES, ZM, a->norm2_g + l * DM, modl + 3 * 1024, rows_out, gw, ngw, lane);
            }
        }
        if (ph + 1 < ph_hi) { for (int sr = 0; sr < sync_rep; ++sr) { if (ph_hi > 100000) grid.sync(); else xcd_barrier(xbar); } }
        { const int kk = (ph == 0) ? 9 : (ph - 1) % 9; const int nrep = (ph < N_PHASES - 1 && ((rep_mask >> kk) & 1)) ? ((kk == 5 || kk == 8) ? 3 : 2) : 1;
          if (rep + 1 < nrep) ++rep; else { rep = 0; ++ph; } }
    }
}

#ifndef MK_MULTI
#define MK_MULTI 0
#endif
extern "C" void kernel_launch(void* const* d_in, const int* in_sizes, int n_in, void* d_out, int out_size, void* d_ws, size_t ws_size, hipStream_t stream) {
    static int grid = 0;
    if (grid == 0) {
        if (n_in != 21 || ws_size < WS_END) { fprintf(stderr, "kernel_launch: unexpected n_in %d or ws_size %zu (< %zu)\n", n_in, ws_size, (size_t)WS_END); grid = -1; return; }
        int dev = 0, cus = 0;
        if (hipGetDevice(&dev) != hipSuccess || hipDeviceGetAttribute(&cus, hipDeviceAttributeMultiprocessorCount, dev) != hipSuccess) { grid = -1; return; }
        if (hipFuncSetAttribute((const void*)fwd_kernel, hipFuncAttributeMaxDynamicSharedMemorySize, LDS_BYTES) != hipSuccess) { fprintf(stderr, "kernel_launch: hipFuncSetAttribute failed\n"); grid = -1; return; }
        int per_cu = 0;
        if (hipOccupancyMaxActiveBlocksPerMultiprocessor(&per_cu, (const void*)fwd_kernel, NT, LDS_BYTES) != hipSuccess || per_cu < 1) { fprintf(stderr, "kernel_launch: occupancy query says %d\n", per_cu); per_cu = 1; }
        (void)hipGetLastError();
        grid = cus;
    }
    if (grid < 0) return;
    if (hipMemsetAsync((char*)d_ws + WS_BAR, 0, BAR_ZERO_BYTES, stream) != hipSuccess) { fprintf(stderr, "kernel_launch: memset failed\n"); return; }
    Args a{};
    const float** ap = (const float**)&a;
    for (int i = 0; i < 21; ++i) ap[i] = (const float*)d_in[i];
    a.out = (float*)d_out; a.ws = (unsigned char*)d_ws; a.rep_mask = REP_MASK; a.sync_rep = SYNC_REP;
#if MK_MULTI
    for (int ph = 0; ph < N_PHASES; ++ph) { a.ph_lo = ph; a.ph_hi = ph + 1; hipLaunchKernelGGL(fwd_kernel, dim3(grid), dim3(NT), LDS_BYTES, stream, a); }
#else
    a.ph_lo = 0; a.ph_hi = N_PHASES;
    void* args[] = {&a};
    hipError_t e = hipLaunchCooperativeKernel((const void*)fwd_kernel, dim3(grid), dim3(NT), args, LDS_BYTES, stream);
    if (e != hipSuccess) fprintf(stderr, "cooperative launch failed: %s (grid %d)\n", hipGetErrorString(e), grid);
#endif
}
```

```cpp
#include <hip/hip_runtime.h>
#include <hip/hip_cooperative_groups.h>
#include <cstdio>
#include <cstdint>
namespace cg = cooperative_groups;
namespace pg8 {
#define PG8_LAS __attribute__((address_space(3)))
typedef unsigned short bf16_t;
typedef short bf16x8 __attribute__((ext_vector_type(8)));
typedef float f32x4 __attribute__((ext_vector_type(4)));
typedef unsigned u32x4 __attribute__((ext_vector_type(4)));
constexpr int BM = 256, BK = 64, HALF = 128, HTB = HALF * BK * 2  , STAGE_BYTES = 8 * HTB, NXCD = 8, WGM = 8;

__host__ __device__ __forceinline__ int lds_byte(int r, int c) { const int st = (r >> 4) * 2 + (c >> 5), rr = r & 15, cc = c & 31, ob = rr * 64 + cc * 2; return st * 1024 + (ob ^ (((ob >> 9) & 1) << 5)); }
__host__ __device__ __forceinline__ void stage_rc(int b, int& R, int& C) { const int st = b / 1024, sb = b % 1024, swz = sb ^ (((sb >> 9) & 1) << 5); R = (st >> 1) * 16 + swz / 64; C = (st & 1) * 32 + (swz % 64) / 2; }
__host__ __device__ __forceinline__ int perm32(int rho) { const int n = rho >> 4, i = rho & 15; return 8 * (i >> 2) + 4 * n + (i & 3); }

struct Unit { int pm, pn; };
struct Gemm { const bf16_t* A; const bf16_t* Bt; int M, N, K; };

struct StaticOrder {
    int nM, nN, nwg, G, c;
    __host__ __device__ void init(int M, int N, int G_, int c_) { nM = M / BM; nN = N / BM; nwg = nM * nN; G = G_; c = c_; }
    __host__ __device__ bool next(int i, Unit& u) const {
        const long L = (long)i * G + c; if (L >= nwg) return false;
        int wgid = (int)L; { const int q = nwg / NXCD, r = nwg % NXCD, xcd = wgid % NXCD, off = wgid / NXCD; wgid = (xcd < r ? xcd * (q + 1) : r * (q + 1) + (xcd - r) * q) + off; }
        const int nig = WGM * nN, gid = wgid / nig, fm = gid * WGM, gsz = (nM - fm) < WGM ? (nM - fm) : WGM;
        u.pm = fm + ((wgid % nig) % gsz); u.pn = (wgid % nig) / gsz; return true;
    }
    __device__ __forceinline__ void a_ready(const Unit&) const {}
    __device__ __forceinline__ void done(const Unit&) const {}
};
__device__ __forceinline__ unsigned cvt_pk_bf16(float lo, float hi) { unsigned r; asm volatile("v_cvt_pk_bf16_f32 %0, %1, %2" : "=v"(r) : "v"(lo), "v"(hi)); return r; }
typedef float f32x2 __attribute__((ext_vector_type(2)));
__device__ __forceinline__ float silu_f(float x) { return x * __builtin_amdgcn_rcpf(1.0f + __builtin_amdgcn_exp2f(-1.4426950408889634f * x)); }
__device__ __forceinline__ float gelu_tanh_f(float x) { return x * __builtin_amdgcn_rcpf(1.0f + __builtin_amdgcn_exp2f(-2.3022082f * (x + 0.044715f * x * x * x))); }

struct EpiIn {
    static constexpr bool PERM = true, AFTER_DRAIN = false;
    bf16_t* P; const float* rope;
    __device__ __forceinline__ void operator()(const f32x4 (&acc)[2][2][4][2], const Unit& u, int wr, int wc, int fr, int fq) const {
        const int pn = u.pn; const bool latent = u.pm < 128;
        const int row0 = u.pm * BM + wr * 64 + fr;
        const int half = wc & 1;
        const bool roped = latent && (pn < 2 || (pn >= 4 && pn <= 6));
        float inv[4];
#pragma unroll
        for (int i = 0; i < 4; ++i) inv[i] = exp2f(-(float)(4 * fq + i) * (13.287712379549449f / 16.0f));
#pragma unroll
        for (int ai = 0; ai < 2; ++ai)
#pragma unroll
            for (int m = 0; m < 4; ++m) {
                const int row = row0 + ai * HALF + m * 16;
                const int t = row & 16383; const int pos = half ? (t & 63) : (t >> 6);
                bf16_t* rowp = P + (size_t)row * 2304 + pn * BM + wc * 32 + 8 * fq;
                f32x4 cs0 = (f32x4){1.f, 0.f, 1.f, 0.f}, cs1 = cs0;
                if (roped) { const float p = (float)pos; const float a0 = p * inv[0], a1 = p * inv[1], a2 = p * inv[2], a3 = p * inv[3];
                    cs0 = (f32x4){__cosf(a0), __sinf(a0), __cosf(a1), __sinf(a1)}; cs1 = (f32x4){__cosf(a2), __sinf(a2), __cosf(a3), __sinf(a3)}; }
#pragma unroll
                for (int bj = 0; bj < 2; ++bj) {
                    f32x4 v0 = acc[ai][bj][m][0], v1 = acc[ai][bj][m][1];
                    int kind = 0; float sc = 1.f;
                    if (pn == 0) kind = 1;
                    else if (pn == 1) { kind = 1; sc = 0.125f; }
                    else if (pn == 3) kind = 2;
                    else if (pn == 4 || pn == 5) { kind = 1; sc = 0.125f * 1.4426950408889634f; }
                    else if (pn == 6) kind = (bj == 0) ? 1 : 0;
                    else if (pn >= 7) kind = 3;
                    if (kind == 1) {
                        f32x4 a, b;
                        a[0] = v0[0] * cs0[0] - v0[1] * cs0[1]; a[1] = v0[1] * cs0[0] + v0[0] * cs0[1];
                        a[2] = v0[2] * cs0[2] - v0[3] * cs0[3]; a[3] = v0[3] * cs0[2] + v0[2] * cs0[3];
                        b[0] = v1[0] * cs1[0] - v1[1] * cs1[1]; b[1] = v1[1] * cs1[0] + v1[0] * cs1[1];
                        b[2] = v1[2] * cs1[2] - v1[3] * cs1[3]; b[3] = v1[3] * cs1[2] + v1[2] * cs1[3];
                        v0 = a * sc; v1 = b * sc;
                    } else if (kind == 2) {
#pragma unroll
                        for (int j = 0; j < 4; ++j) { v0[j] = silu_f(v0[j]); v1[j] = silu_f(v1[j]); }
                    } else if (kind == 3) {
#pragma unroll
                        for (int j = 0; j < 4; ++j) { v0[j] = gelu_tanh_f(v0[j]); v1[j] = gelu_tanh_f(v1[j]); }
                    }
                    u32x4 w; w.x = cvt_pk_bf16(v0[0], v0[1]); w.y = cvt_pk_bf16(v0[2], v0[3]); w.z = cvt_pk_bf16(v1[0], v1[1]); w.w = cvt_pk_bf16(v1[2], v1[3]);
                    *(u32x4*)(rowp + bj * HALF) = w;
                }
            }
    }
};
struct EpiRes {
    static constexpr bool PERM = true, AFTER_DRAIN = false;
    float* X; const float* Xsrc; const float* gate0; float sgn;
    __device__ __forceinline__ void operator()(const f32x4 (&acc)[2][2][4][2], const Unit& u, int wr, int wc, int fr, int fq) const {
        const int s = u.pm < 64 ? 0 : (u.pm < 128 ? 1 : 2);
        const float* gv = gate0 + s * 6144;
        const int row0 = u.pm * BM + wr * 64 + fr, col0 = u.pn * BM + wc * 32 + 8 * fq;
        f32x4 g[2][2];
#pragma unroll
        for (int bj = 0; bj < 2; ++bj)
#pragma unroll
            for (int n = 0; n < 2; ++n) g[bj][n] = *(const f32x4*)(gv + col0 + bj * HALF + n * 4) * sgn;
#pragma unroll
        for (int ai = 0; ai < 2; ++ai)
#pragma unroll
            for (int mp = 0; mp < 2; ++mp) {
                f32x4 xv[2][2][2];
#pragma unroll
                for (int mm = 0; mm < 2; ++mm) { const float* rowp = Xsrc + (size_t)(row0 + ai * HALF + (2 * mp + mm) * 16) * 1024 + col0;
#pragma unroll
                    for (int bj = 0; bj < 2; ++bj)
#pragma unroll
                        for (int n = 0; n < 2; ++n) xv[mm][bj][n] = *(const f32x4*)(rowp + bj * HALF + n * 4); }
#pragma unroll
                for (int mm = 0; mm < 2; ++mm) { float* rowp = X + (size_t)(row0 + ai * HALF + (2 * mp + mm) * 16) * 1024 + col0;
#pragma unroll
                    for (int bj = 0; bj < 2; ++bj)
#pragma unroll
                        for (int n = 0; n < 2; ++n) *(f32x4*)(rowp + bj * HALF + n * 4) = xv[mm][bj][n] + g[bj][n] * acc[ai][bj][2 * mp + mm][n]; }
                asm volatile("" ::: "memory");
            }
    }
};
struct EpiGU {
    static constexpr bool PERM = true, AFTER_DRAIN = false;
    bf16_t* H;
    __device__ __forceinline__ void operator()(const f32x4 (&acc)[2][2][4][2], const Unit& u, int wr, int wc, int fr, int fq) const {
        const int row0 = u.pm * BM + wr * 64 + fr, hid0 = u.pn * HALF + wc * 32 + 8 * fq;
#pragma unroll
        for (int ai = 0; ai < 2; ++ai)
#pragma unroll
            for (int m = 0; m < 4; ++m) { bf16_t* rowp = H + (size_t)(row0 + ai * HALF + m * 16) * 2816 + hid0;
                f32x4 g0 = acc[ai][0][m][0], g1 = acc[ai][0][m][1]; const f32x4 u0 = acc[ai][1][m][0], u1 = acc[ai][1][m][1];
#pragma unroll
                for (int j = 0; j < 4; ++j) { g0[j] = silu_f(g0[j]) * u0[j]; g1[j] = silu_f(g1[j]) * u1[j]; }
                u32x4 w; w.x = cvt_pk_bf16(g0[0], g0[1]); w.y = cvt_pk_bf16(g0[2], g0[3]); w.z = cvt_pk_bf16(g1[0], g1[1]); w.w = cvt_pk_bf16(g1[2], g1[3]);
                *(u32x4*)rowp = w; }
    }
};

struct EpiAll {
    static constexpr bool AFTER_DRAIN = false;
    int mode; bool perm, align; EpiIn ein; EpiRes eres; EpiGU egu;
    __device__ __forceinline__ void operator()(const f32x4 (&acc)[2][2][4][2], const Unit& u, int wr, int wc, int fr, int fq) const {
        if (mode == 0) ein(acc, u, wr, wc, fr, fq); else if (mode == 1) eres(acc, u, wr, wc, fr, fq); else egu(acc, u, wr, wc, fr, fq);
    }
};

template <class Epi, class Sched, bool ALIGN_EPI = false, bool SP2 = false>
__device__ __forceinline__ void gemm_phase(PG8_LAS unsigned char* lds, const Gemm g, const Sched& S, const Epi& E) {
    int tid_o = threadIdx.x; asm volatile("" : "+v"(tid_o));
    const int tid = tid_o, wid = __builtin_amdgcn_readfirstlane(tid >> 6), lane = tid & 63, wr = wid >> 2, wc = wid & 3, fr = lane & 15, fq = lane >> 4;
    const int K = g.K, nt = K / BK;
    unsigned voffA[2], voffB[2];
#pragma unroll
    for (int i = 0; i < 2; ++i) { int R, C; stage_rc(tid * 16 + i * 8192, R, C); const int Rb = E.perm ? ((R & ~31) + perm32(R & 31)) : R;
        voffA[i] = (unsigned)(R * K + C) * 2u; voffB[i] = (unsigned)(Rb * K + C) * 2u; }
    const size_t kstep = (size_t)(BK * 2);
    const size_t hstep = (size_t)HALF * K * 2;
    const size_t tstep = 2 * hstep;
    const unsigned ldsw = (unsigned)wid * 1024u;
    const int aoff = lds_byte(wr * 64 + fr, fq * 8), boff = lds_byte(wc * 32 + fr, fq * 8);
#define PG8_SA(b, h) (((b) * 2 + (h)) * HTB)
#define PG8_SB(b, h) ((4 + (b) * 2 + (h)) * HTB)
#define PG8_STAGE(bufoff, gbase, voff) do { _Pragma("unroll") for (int _i = 0; _i < 2; ++_i) \
        __builtin_amdgcn_global_load_lds((const unsigned*)((const char*)(gbase) + (voff)[_i]), (PG8_LAS unsigned*)(lds + (bufoff) + ldsw + _i * 8192), 16, 0, 0); } while (0)
#define PG8_LDA(dst, b, h) do { _Pragma("unroll") for (int m = 0; m < 4; ++m) _Pragma("unroll") for (int k = 0; k < 2; ++k) dst[m][k] = *(const PG8_LAS bf16x8*)(lds + PG8_SA(b, h) + aoff + m * 2048 + k * 1024); } while (0)
#define PG8_LDB(dst, b, h) do { _Pragma("unroll") for (int n = 0; n < 2; ++n) _Pragma("unroll") for (int k = 0; k < 2; ++k) dst[n][k] = *(const PG8_LAS bf16x8*)(lds + PG8_SB(b, h) + boff + n * 2048 + k * 1024); } while (0)
#define PG8_MMA(ai, bj, At, Bt) do { __builtin_amdgcn_s_setprio(1); _Pragma("unroll") for (int m = 0; m < 4; ++m) _Pragma("unroll") for (int n = 0; n < 2; ++n) _Pragma("unroll") for (int k = 0; k < 2; ++k) \
        acc[ai][bj][m][n] = __builtin_amdgcn_mfma_f32_16x16x32_bf16(Bt[n][k], At[m][k], acc[ai][bj][m][n], 0, 0, 0); __builtin_amdgcn_s_setprio(0); } while (0)
#define PG8_WAIT_V(n) asm volatile("s_waitcnt vmcnt(" #n ")" ::: "memory")
#define PG8_WAIT_L(n) asm volatile("s_waitcnt lgkmcnt(" #n ")" ::: "memory")
#define PG8_BAR __builtin_amdgcn_s_barrier()
#define PG8_SCHED __builtin_amdgcn_sched_barrier(0)
    Unit cur, nxt; int ui = 0;
    if (!S.next(0, cur)) return;
    f32x4 acc[2][2][4][2];
#pragma unroll
    for (int a = 0; a < 2; ++a)
#pragma unroll
        for (int b = 0; b < 2; ++b)
#pragma unroll
            for (int m = 0; m < 4; ++m)
#pragma unroll
                for (int n = 0; n < 2; ++n) acc[a][b][m][n] = (f32x4){0.f, 0.f, 0.f, 0.f};
    bf16x8 At[4][2], B0[2][2], B1[2][2];
    const char* cA = (const char*)g.A + (size_t)cur.pm * tstep; const char* cB = (const char*)g.Bt + (size_t)cur.pn * tstep;
    S.a_ready(cur);
    if constexpr (SP2) {
        PG8_STAGE(PG8_SB(0, 0), cB, voffB); PG8_STAGE(PG8_SB(0, 1), cB + hstep, voffB); PG8_STAGE(PG8_SA(0, 0), cA, voffA); PG8_STAGE(PG8_SA(0, 1), cA + hstep, voffA);
        if (wr == 1) PG8_BAR;
        PG8_WAIT_V(2); PG8_BAR;
        PG8_STAGE(PG8_SB(1, 0), cB + kstep, voffB); PG8_STAGE(PG8_SA(1, 0), cA + kstep, voffA); PG8_STAGE(PG8_SB(1, 1), cB + hstep + kstep, voffB);
        PG8_WAIT_V(6); PG8_BAR;
    } else {
        PG8_STAGE(PG8_SB(0, 0), cB, voffB); PG8_STAGE(PG8_SA(0, 0), cA, voffA); PG8_STAGE(PG8_SB(0, 1), cB + hstep, voffB); PG8_STAGE(PG8_SA(0, 1), cA + hstep, voffA);
        if (wr == 1) PG8_BAR;
        PG8_WAIT_V(4); PG8_BAR;
        PG8_STAGE(PG8_SB(1, 0), cB + kstep, voffB); PG8_STAGE(PG8_SA(1, 0), cA + kstep, voffA); PG8_STAGE(PG8_SB(1, 1), cB + hstep + kstep, voffB);
        PG8_WAIT_V(6); PG8_BAR;
    }
    for (;;) {
        const bool has_next = S.next(ui + 1, nxt);
        const char* nA = has_next ? (const char*)g.A + (size_t)nxt.pm * tstep : cA; const char* nB = has_next ? (const char*)g.Bt + (size_t)nxt.pn * tstep : cB;
        for (int t = 0; t < nt; t += 2) {
            const bool last = (t == nt - 2);
            const char* a1 = cA + (size_t)(t + 1) * kstep;
            const char* a2 = last ? nA : cA + (size_t)(t + 2) * kstep; const char* b2 = last ? nB : cB + (size_t)(t + 2) * kstep;
            const char* a3 = a2 + kstep; const char* b3 = b2 + kstep;
            if (last && has_next) S.a_ready(nxt);
            if constexpr (SP2) {
            PG8_LDB(B0, 0, 0); PG8_LDB(B1, 0, 1); PG8_SCHED; PG8_LDA(At, 0, 0); PG8_STAGE(PG8_SA(1, 1), a1 + hstep, voffA);
            PG8_WAIT_V(8); PG8_WAIT_L(0); PG8_BAR; PG8_MMA(0, 0, At, B0); PG8_MMA(0, 1, At, B1); PG8_BAR; PG8_SCHED;
            PG8_LDA(At, 0, 1); PG8_STAGE(PG8_SB(0, 0), b2, voffB); PG8_STAGE(PG8_SB(0, 1), b2 + hstep, voffB); PG8_STAGE(PG8_SA(0, 0), a2, voffA);
            PG8_WAIT_V(8); PG8_WAIT_L(0); PG8_BAR; PG8_MMA(1, 0, At, B0); PG8_MMA(1, 1, At, B1); PG8_BAR; PG8_SCHED;
            PG8_LDB(B0, 1, 0); PG8_LDB(B1, 1, 1); PG8_SCHED; PG8_LDA(At, 1, 0); PG8_STAGE(PG8_SA(0, 1), a2 + hstep, voffA);
            PG8_WAIT_V(8); PG8_WAIT_L(0); PG8_BAR; PG8_MMA(0, 0, At, B0); PG8_MMA(0, 1, At, B1); PG8_BAR; PG8_SCHED;
            PG8_LDA(At, 1, 1); PG8_STAGE(PG8_SB(1, 0), b3, voffB); PG8_STAGE(PG8_SB(1, 1), b3 + hstep, voffB); PG8_STAGE(PG8_SA(1, 0), a3, voffA);
            PG8_WAIT_V(8); PG8_WAIT_L(0); PG8_BAR; PG8_MMA(1, 0, At, B0); PG8_MMA(1, 1, At, B1); PG8_BAR; PG8_SCHED;
            } else {
            PG8_LDB(B0, 0, 0); PG8_SCHED; PG8_LDA(At, 0, 0); PG8_STAGE(PG8_SA(1, 1), a1 + hstep, voffA);
            PG8_WAIT_L(8); PG8_BAR; PG8_WAIT_L(0); PG8_MMA(0, 0, At, B0); PG8_BAR; PG8_SCHED;
            PG8_LDB(B1, 0, 1); PG8_STAGE(PG8_SB(0, 0), b2, voffB);
            PG8_BAR; PG8_WAIT_L(0); PG8_MMA(0, 1, At, B1); PG8_BAR;
            PG8_LDA(At, 0, 1); PG8_STAGE(PG8_SA(0, 0), a2, voffA);
            PG8_BAR; PG8_WAIT_L(0); PG8_MMA(1, 0, At, B0); PG8_BAR; PG8_SCHED;
            PG8_STAGE(PG8_SB(0, 1), b2 + hstep, voffB);
            PG8_WAIT_V(6); PG8_BAR; PG8_MMA(1, 1, At, B1); PG8_BAR;
            PG8_LDB(B0, 1, 0); PG8_SCHED; PG8_LDA(At, 1, 0); PG8_STAGE(PG8_SA(0, 1), a2 + hstep, voffA);
            PG8_WAIT_L(8); PG8_BAR; PG8_WAIT_L(0); PG8_MMA(0, 0, At, B0); PG8_BAR; PG8_SCHED;
            PG8_LDB(B1, 1, 1); PG8_STAGE(PG8_SB(1, 0), b3, voffB);
            PG8_BAR; PG8_WAIT_L(0); PG8_MMA(0, 1, At, B1); PG8_BAR;
            PG8_LDA(At, 1, 1); PG8_STAGE(PG8_SA(1, 0), a3, voffA);
            PG8_BAR; PG8_WAIT_L(0); PG8_MMA(1, 0, At, B0); PG8_BAR; PG8_SCHED;
            PG8_STAGE(PG8_SB(1, 1), b3 + hstep, voffB);
            PG8_WAIT_V(6); PG8_BAR; PG8_MMA(1, 1, At, B1); PG8_BAR;
            }
        }
        if (E.align) { if (wr == 0) PG8_BAR; }
        if constexpr (!Epi::AFTER_DRAIN) { E(acc, cur, wr, wc, fr, fq); S.done(cur); }
        if (!has_next) break;
#pragma unroll
        for (int a = 0; a < 2; ++a)
#pragma unroll
            for (int b = 0; b < 2; ++b)
#pragma unroll
                for (int m = 0; m < 4; ++m)
#pragma unroll
                    for (int n = 0; n < 2; ++n) acc[a][b][m][n] = (f32x4){0.f, 0.f, 0.f, 0.f};
        cur = nxt; cA = nA; cB = nB; ++ui;
        if (E.align) { if (wr == 1) PG8_BAR; }
    }
    PG8_WAIT_V(0);
    if (!E.align) { if (wr == 0) PG8_BAR; }
    PG8_BAR;
    if constexpr (Epi::AFTER_DRAIN) { E.fused(acc, cur, wr, wc, fr, fq, lds, wid, lane); S.done(cur); }
#undef PG8_SA
#undef PG8_SB
#undef PG8_STAGE
#undef PG8_LDA
#undef PG8_LDB
#undef PG8_MMA
#undef PG8_WAIT_V
#undef PG8_WAIT_L
#undef PG8_BAR
#undef PG8_SCHED
}
}

#define LAS __attribute__((address_space(3)))
typedef unsigned short bf16;
typedef float f32x4 __attribute__((ext_vector_type(4)));
typedef unsigned u32x4v __attribute__((ext_vector_type(4)));
typedef unsigned u32x2v __attribute__((ext_vector_type(2)));
constexpr int NWAVES = 8, NT = 512;
constexpr int DM = 1024, SEQ = 16384, R_LAT = 32768, R_CTX = 512, R_ALL = 33280, INW = 2304, FF = 2816, GUW = 5632, DEPTH = 4;
constexpr int C_RQ = 0, C_RK = 256, C_RV = 512, C_RG = 768, C_AQ = 1024, C_AK = 1536, C_AV = 1664, C_CU = 1792, C_CV = 2048;
constexpr int NCHUNK = 260;
constexpr float LOG2E = 1.4426950408889634f;
constexpr float EPS = 1e-6f;
constexpr size_t MiB = 1u << 20;
constexpr size_t WS_BAR = 0, BAR_ZERO_BYTES = 16384;
constexpr size_t WS_MOD = 1 * MiB;
constexpr size_t WS_ROPE = WS_MOD + 512 * 1024;
constexpr size_t WS_DEC = WS_MOD + 768 * 1024;
constexpr size_t WS_W0 = 2 * MiB, WBUF_BYTES = 24 * MiB;
constexpr size_t WO_IN = 0, WO_OUT = (size_t)INW * DM * 2, WO_GU = WO_OUT + (size_t)DM * DM * 2, WO_DN = WO_GU + (size_t)GUW * DM * 2, WO_WS = WO_DN + (size_t)DM * FF * 2, WO_END = WO_WS + 4 * 128 * 128 * 2;
static_assert(WO_END <= WBUF_BYTES, "weight buffer");
constexpr size_t WS_X = WS_W0 + 2 * WBUF_BYTES;
constexpr size_t WS_ZM = WS_X + 130 * MiB;
constexpr size_t WS_PH = WS_ZM + 65 * MiB;
constexpr size_t WS_D = WS_PH + 179 * MiB;
constexpr size_t WS_S = WS_D + 33 * MiB;
constexpr size_t WS_END = WS_S + 17 * MiB;
static_assert((size_t)R_ALL * DM * 4 <= 130 * MiB && (size_t)R_ALL * DM * 2 <= 65 * MiB && (size_t)R_ALL * FF * 2 <= 179 * MiB && (size_t)NCHUNK * 8 * 4096 * 4 <= 33 * MiB, "ws map");
constexpr int LDS_BYTES = 147456;

struct Args {
    const float *x, *c, *ctx, *c_ctx, *w_mod, *b_mod, *norm1_g, *norm2_g, *w_in, *ret_decay_f, *ret_decay_b, *ret_norm_g, *attn_sink, *cm_norm_g, *cm_w_s, *cm_b_s, *w_out, *w_gate, *w_up, *w_down, *final_norm_g;
    float* out; unsigned char* ws; int ph_lo, ph_hi, rep_mask, sync_rep;
};

typedef const __attribute__((address_space(4))) Args* KArgs;

__device__ __forceinline__ float bf_lo(unsigned w) { return __uint_as_float(w << 16); }
__device__ __forceinline__ float bf_hi(unsigned w) { return __uint_as_float(w & 0xffff0000u); }
__device__ __forceinline__ unsigned f2bf(float f) { unsigned u = __float_as_uint(f); return (u + 0x7fffu + ((u >> 16) & 1u)) >> 16; }
__device__ __forceinline__ unsigned pk2(float lo, float hi) { return pg8::cvt_pk_bf16(lo, hi); }
__device__ __forceinline__ float wave_sum(float v) {
#pragma unroll
    for (int o = 1; o < 64; o <<= 1) v += __shfl_xor(v, o);
    return v;
}
__device__ __forceinline__ float log_sigmoid_f(float x) { return -log1pf(expf(-x)); }
#define UNPACK8(dst, off, PW) do { dst[(off) + 0] = bf_lo((PW)[0]); dst[(off) + 1] = bf_hi((PW)[0]); dst[(off) + 2] = bf_lo((PW)[1]); dst[(off) + 3] = bf_hi((PW)[1]); \
    dst[(off) + 4] = bf_lo((PW)[2]); dst[(off) + 5] = bf_hi((PW)[2]); dst[(off) + 6] = bf_lo((PW)[3]); dst[(off) + 7] = bf_hi((PW)[3]); } while (0)

template <int MAP> __device__ __forceinline__ int map_col(int n) {
    if (MAP == 1) { const bool qk = (n < 512) || (n >= 1024 && n < 1664); if (!qk) return n; const int d = n & 63, hf = d >> 5, w = d & 31, j = w & 15, sec = w >> 4; return (n & ~63) + hf * 32 + 2 * j + sec; }
    if (MAP == 2) return 256 * (n >> 7) + (n & 127);
    if (MAP == 3) return 256 * (n >> 7) + 128 + (n & 127);
    return n;
}
template <int MAP> __device__ __forceinline__ void transpose_item(const float* W, int K, int N, bf16* WT, LAS float* scr, int item, int lane) {
    const int nblk = N / 32, kb = item / nblk, nb = item % nblk, k0 = 64 * kb, n0 = 32 * nb;
#pragma unroll 8
    for (int i = 0; i < 32; ++i) { const int kk = 2 * i + (lane >> 5); scr[kk * 33 + (lane & 31)] = W[(size_t)(k0 + kk) * N + n0 + (lane & 31)]; }
    asm volatile("s_waitcnt lgkmcnt(0)" ::: "memory");
    const int c = lane & 7;
#pragma unroll
    for (int j = 0; j < 4; ++j) { const int n = (lane >> 3) + 8 * j; const LAS float* s = scr + (8 * c) * 33 + n;
        u32x4v o; o.x = pk2(s[0 * 33], s[1 * 33]); o.y = pk2(s[2 * 33], s[3 * 33]); o.z = pk2(s[4 * 33], s[5 * 33]); o.w = pk2(s[6 * 33], s[7 * 33]);
        *(u32x4v*)(WT + (size_t)map_col<MAP>(n0 + n) * K + k0 + 8 * c) = o; }
    asm volatile("s_waitcnt lgkmcnt(0)" ::: "memory");
}
__device__ __forceinline__ void convert_weights(KArgs a, int l, unsigned char* wb, LAS unsigned char* lds, int gw, int ngw, int wave, int lane) {
    LAS float* scr = (LAS float*)(lds + wave * 16384);
    constexpr int I_IN = 16 * 72, I_OUT = 16 * 32, I_G = 16 * 88, I_D = 44 * 32, I_WS = 16;
    constexpr int NIT = I_IN + I_OUT + 2 * I_G + I_D + I_WS;
    for (int it = gw; it < NIT; it += ngw) {
        int r = it;
        if (r < I_IN) { transpose_item<1>(a->w_in + (size_t)l * DM * INW, DM, INW, (bf16*)(wb + WO_IN), scr, r, lane); continue; } r -= I_IN;
        if (r < I_OUT) { transpose_item<0>(a->w_out + (size_t)l * DM * DM, DM, DM, (bf16*)(wb + WO_OUT), scr, r, lane); continue; } r -= I_OUT;
        if (r < I_G) { transpose_item<2>(a->w_gate + (size_t)l * DM * FF, DM, FF, (bf16*)(wb + WO_GU), scr, r, lane); continue; } r -= I_G;
        if (r < I_G) { transpose_item<3>(a->w_up + (size_t)l * DM * FF, DM, FF, (bf16*)(wb + WO_GU), scr, r, lane); continue; } r -= I_G;
        if (r < I_D) { transpose_item<0>(a->w_down + (size_t)l * FF * DM, FF, DM, (bf16*)(wb + WO_DN), scr, r, lane); continue; } r -= I_D;
        { const float* src = a->cm_w_s + (size_t)l * 65536 + r * 4096; bf16* dst = (bf16*)(wb + WO_WS) + r * 4096;
            for (int i = lane; i < 1024; i += 64) { const f32x4 v = *(const f32x4*)(src + 4 * i); u32x2v o; o.x = pk2(v[0], v[1]); o.y = pk2(v[2], v[3]); *(u32x2v*)(dst + 4 * i) = o; } }
    }
}
__device__ __forceinline__ void mod_phase(KArgs a, float* MOD, LAS unsigned char* lds, int bid, int G, int tid) {
    LAS float* sc = (LAS float*)lds;
    LAS float* red = (LAS float*)(lds + 16384);
    for (int i = tid; i < 3072; i += NT) { const float v = i < 2048 ? a->c[i] : a->c_ctx[i - 2048]; sc[i] = v / (1.0f + __expf(-v)); }
    __syncthreads();
    const int cx = tid & 31, ks = tid >> 5;
    for (int it = bid; it < 4 * 48; it += G) {
        const int l = it / 48, cb = it % 48;
        const float* W = a->w_mod + (size_t)l * DM * 6144 + cb * 128 + cx * 4;
        f32x4 a0 = {0.f, 0.f, 0.f, 0.f}, a1 = a0, a2 = a0;
#pragma unroll 4
        for (int k = ks * 64; k < ks * 64 + 64; ++k) { const f32x4 w = *(const f32x4*)(W + (size_t)k * 6144); a0 += w * sc[k]; a1 += w * sc[1024 + k]; a2 += w * sc[2048 + k]; }
        *(LAS f32x4*)(red + (ks * 3 + 0) * 128 + cx * 4) = a0; *(LAS f32x4*)(red + (ks * 3 + 1) * 128 + cx * 4) = a1; *(LAS f32x4*)(red + (ks * 3 + 2) * 128 + cx * 4) = a2;
        __syncthreads();
        if (tid < 384) { const int s = tid >> 7, col = tid & 127; float v = a->b_mod[l * 6144 + cb * 128 + col];
#pragma unroll
            for (int k = 0; k < 16; ++k) v += red[(k * 3 + s) * 128 + col];
            MOD[(size_t)(l * 3 + s) * 6144 + cb * 128 + col] = v; }
        __syncthreads();
    }
}
template <int MODE> __device__ __forceinline__ void norm_phase(KArgs a, float* XRES, bf16* ZN, const float* gvec, const float* mod_shift  , int nrows, int gw, int ngw, int lane) {
    f32x4 gm[4], hs[4]; int scur = -1;
#define NIDX(j) (2 * lane + 128 * ((j) >> 1) + ((j) & 1))
    if (MODE == 2) {
#pragma unroll
        for (int j = 0; j < 4; ++j) gm[j] = *((const f32x4*)gvec + NIDX(j)); }
    for (int row = gw; row < nrows; row += ngw) {
        const float* src = (MODE == 1) ? (row < R_LAT ? a->x + (size_t)row * DM : a->ctx + (size_t)(row - R_LAT) * DM) : XRES + (size_t)row * DM;
        const f32x4* xr = (const f32x4*)src;
        f32x4 v[4]; float ss = 0.f;
#pragma unroll
        for (int j = 0; j < 4; ++j) { v[j] = xr[NIDX(j)]; ss += (v[j][0] * v[j][0] + v[j][1] * v[j][1]) + (v[j][2] * v[j][2] + v[j][3] * v[j][3]); }
        if (MODE != 2) { const int s = row < SEQ ? 0 : (row < R_LAT ? 1 : 2);
            if (s != scur) { scur = s; const float* sh = mod_shift + s * 6144; const float* scl = sh + 1024;
#pragma unroll
                for (int j = 0; j < 4; ++j) { gm[j] = *((const f32x4*)gvec + NIDX(j)) * (*((const f32x4*)scl + NIDX(j)) + 1.0f); hs[j] = *((const f32x4*)sh + NIDX(j)); } } }
        const float rstd = __builtin_amdgcn_rsqf(wave_sum(ss) * (1.0f / DM) + EPS);
        if (MODE == 2) { f32x4* o = (f32x4*)(a->out + (size_t)row * DM);
#pragma unroll
            for (int j = 0; j < 4; ++j) o[NIDX(j)] = v[j] * rstd * gm[j]; }
        else { u32x4v* o = (u32x4v*)(ZN + (size_t)row * DM);
#pragma unroll
            for (int h = 0; h < 2; ++h) { const f32x4 z0 = v[2 * h] * rstd * gm[2 * h] + hs[2 * h], z1 = v[2 * h + 1] * rstd * gm[2 * h + 1] + hs[2 * h + 1];
                u32x4v w; w[0] = pk2(z0[0], z0[1]); w[1] = pk2(z0[2], z0[3]); w[2] = pk2(z1[0], z1[1]); w[3] = pk2(z1[2], z1[3]); o[lane + 64 * h] = w; } }
    }
#undef NIDX
}

__device__ __forceinline__ void attn_naive_item(int item, const bf16* P, bf16* MIX, const float* sink, int tid) {
    const int rb = item >> 1, hk = item & 1, g = tid >> 7, r = tid & 127, hq = hk * 4 + g, row = rb * 128 + r;
    float q[64], o[64];
    { const u32x4v* qp = (const u32x4v*)(P + (size_t)row * INW + C_AQ + hq * 64);
#pragma unroll
      for (int i = 0; i < 8; ++i) { const u32x4v w = qp[i]; UNPACK8(q, 8 * i, w); } }
#pragma unroll
    for (int d = 0; d < 64; ++d) o[d] = 0.f;
    float m = -1e30f, lsum = 0.f;
    for (int sg = 0; sg < 4; ++sg) {
        int krow0, nk, mode;
        if (rb < 256) { const int b = rb >> 7, i = rb & 127;
            if (sg == 0) { if (i == 0) continue; krow0 = (rb - 1) * 128; nk = 128; mode = 1; }
            else if (sg == 1) { krow0 = rb * 128; nk = 128; mode = 0; }
            else if (sg == 2) { if (i == 127) continue; krow0 = (rb + 1) * 128; nk = 128; mode = 2; }
            else { krow0 = R_LAT + b * 256; nk = 256; mode = 0; } }
        else { if (sg != 3) continue; const int b = (rb - 256) >> 1; krow0 = R_LAT + b * 256; nk = 256; mode = 0; }
        for (int c = 0; c < nk; ++c) {
            const u32x4v* kp = (const u32x4v*)(P + (size_t)(krow0 + c) * INW + C_AK + hk * 64);
            float s = 0.f;
#pragma unroll
            for (int i = 0; i < 8; ++i) { const u32x4v w = kp[i]; float kk[8]; UNPACK8(kk, 0, w);
#pragma unroll
                for (int e = 0; e < 8; ++e) s += q[8 * i + e] * kk[e]; }
            const bool valid = (mode == 0) || (mode == 1 ? (c >= r) : (c <= r));
            s = valid ? s : -INFINITY;
            const float mn = fmaxf(m, s), al = exp2f(m - mn), p = exp2f(s - mn);
            lsum = lsum * al + p; m = mn;
            const u32x4v* vp = (const u32x4v*)(P + (size_t)(krow0 + c) * INW + C_AV + hk * 64);
#pragma unroll
            for (int i = 0; i < 8; ++i) { const u32x4v w = vp[i]; float vv[8]; UNPACK8(vv, 0, w);
#pragma unroll
                for (int e = 0; e < 8; ++e) o[8 * i + e] = o[8 * i + e] * al + p * vv[e]; }
        }
    }
    { const float sl = sink[hq] * LOG2E, mf = fmaxf(m, sl), al = exp2f(m - mf); lsum = lsum * al + exp2f(sl - mf); const float inv = al / lsum;
      u32x4v* op = (u32x4v*)(MIX + (size_t)row * DM + 256 + hq * 64);
#pragma unroll
      for (int i = 0; i < 8; ++i) { u32x4v w; w.x = pk2(o[8 * i] * inv, o[8 * i + 1] * inv); w.y = pk2(o[8 * i + 2] * inv, o[8 * i + 3] * inv); w.z = pk2(o[8 * i + 4] * inv, o[8 * i + 5] * inv); w.w = pk2(o[8 * i + 6] * inv, o[8 * i + 7] * inv); op[i] = w; } }
}
__device__ __forceinline__ void gmlp_naive_item(int ch, const bf16* P, bf16* MIX, const float* norm_g, const float* w_s, const float* b_s, LAS unsigned char* lds, int tid) {
    LAS float* vn = (LAS float*)lds;
    const int g = tid >> 7, p = tid & 127, row = ch * 128 + p;
    { float v[64]; const u32x4v* vp = (const u32x4v*)(P + (size_t)row * INW + C_CV + g * 64);
#pragma unroll
      for (int i = 0; i < 8; ++i) { const u32x4v w = vp[i]; UNPACK8(v, 8 * i, w); }
      float s = 0.f;
#pragma unroll
      for (int d = 0; d < 64; ++d) s += v[d];
      const float mu = s * (1.0f / 64.0f); float qq = 0.f;
#pragma unroll
      for (int d = 0; d < 64; ++d) { v[d] -= mu; qq += v[d] * v[d]; }
      const float rstd = 1.0f / sqrtf(qq * (1.0f / 64.0f) + EPS);
#pragma unroll
      for (int d = 0; d < 64; ++d) vn[p * 256 + g * 64 + d] = v[d] * rstd * norm_g[g * 64 + d]; }
    __syncthreads();
    float acc[64];
#pragma unroll
    for (int d = 0; d < 64; ++d) acc[d] = 0.f;
    const float* wrow = w_s + (size_t)(g * 128 + p) * 128;
    for (int qi = 0; qi < 128; ++qi) { const float w = wrow[qi]; const LAS f32x4* vr = (const LAS f32x4*)(vn + qi * 256 + g * 64);
#pragma unroll
        for (int i = 0; i < 16; ++i) { const f32x4 x = vr[i]; acc[4 * i] += w * x[0]; acc[4 * i + 1] += w * x[1]; acc[4 * i + 2] += w * x[2]; acc[4 * i + 3] += w * x[3]; } }
    const float bs = b_s[g * 128 + p];
    const u32x4v* up = (const u32x4v*)(P + (size_t)row * INW + C_CU + g * 64); u32x4v* op = (u32x4v*)(MIX + (size_t)row * DM + 768 + g * 64);
#pragma unroll
    for (int i = 0; i < 8; ++i) { const u32x4v w = up[i]; float uu[8]; UNPACK8(uu, 0, w);
#pragma unroll
        for (int e = 0; e < 8; ++e) uu[e] *= (acc[8 * i + e] + bs);
        u32x4v o; o.x = pk2(uu[0], uu[1]); o.y = pk2(uu[2], uu[3]); o.z = pk2(uu[4], uu[5]); o.w = pk2(uu[6], uu[7]); op[i] = o; }
    __syncthreads();
}
__device__ __forceinline__ void retd_naive_item(int item, const bf16* P, float* DB, float l2f, float l2b, LAS unsigned char* lds, int tid) {
    const int ch = item >> 2, h = item & 3;
    LAS float* Ks = (LAS float*)lds; LAS float* Vs = Ks + 8192; LAS float* wf = Vs + 8192; LAS float* wb = wf + 128;
    for (int i = tid; i < 1024; i += NT) { const int j = i >> 3, c8 = (i & 7) * 8; const size_t ro = (size_t)(ch * 128 + j) * INW + h * 64 + c8;
        const u32x4v kw = *(const u32x4v*)(P + ro + C_RK), vw = *(const u32x4v*)(P + ro + C_RV); float t[8];
        UNPACK8(t, 0, kw);
#pragma unroll
        for (int e = 0; e < 8; ++e) Ks[j * 64 + c8 + e] = t[e];
        UNPACK8(t, 0, vw);
#pragma unroll
        for (int e = 0; e < 8; ++e) Vs[j * 64 + c8 + e] = t[e]; }
    if (tid < 128) { wf[tid] = exp2f((float)(127 - tid) * l2f); wb[tid] = exp2f((float)tid * l2b); }
    __syncthreads();
    float* Df = DB + (size_t)(item * 2) * 4096; float* Dbk = Df + 4096;
#pragma unroll 1
    for (int i = 0; i < 8; ++i) { const int e = tid + NT * i, dv = e >> 6, dk = e & 63; float af = 0.f, ab = 0.f;
        for (int j = 0; j < 128; ++j) { const float kv = Ks[j * 64 + dk] * Vs[j * 64 + dv]; af += wf[j] * kv; ab += wb[j] * kv; }
        Df[e] = af; Dbk[e] = ab; }
    __syncthreads();
}
__device__ __forceinline__ void scan_phase(const float* __restrict__ DB, bf16* __restrict__ SB, const float* decay_f, const float* decay_b, int gtid, int gthreads) {
    for (int id = gtid; id < 65536; id += gthreads) {
        const int e = id & 4095, dir = (id >> 12) & 1, h = (id >> 13) & 3, b = id >> 15;
        const float cd = exp2f(128.0f * (dir ? decay_b[h] : decay_f[h]));
        const size_t off = (size_t)(h * 2 + dir) * 4096 + e;
        const int c0 = 256 + 2 * b, c1 = c0 + 1;
        const int first = dir ? c1 : c0, second = dir ? c0 : c1;
        const float d0 = DB[(size_t)first * 32768 + off], d1 = DB[(size_t)second * 32768 + off];
        float s = d0;
        SB[(size_t)first * 32768 + off] = (bf16)0;
        SB[(size_t)second * 32768 + off] = (bf16)f2bf(s); s = s * cd + d1;
#pragma unroll 1
        for (int i0 = 0; i0 < 128; i0 += 32) {
            float d[32];
#pragma unroll
            for (int i = 0; i < 32; ++i) { const int ch = b * 128 + (dir ? 127 - (i0 + i) : (i0 + i)); d[i] = DB[(size_t)ch * 32768 + off]; }
#pragma unroll
            for (int i = 0; i < 32; ++i) { const int ch = b * 128 + (dir ? 127 - (i0 + i) : (i0 + i)); SB[(size_t)ch * 32768 + off] = (bf16)f2bf(s); s = s * cd + d[i]; }
        }
    }
}
__device__ __forceinline__ void reto_naive_item(int item, const bf16* P, const bf16* SB, bf16* MIX, const float* norm_g, float l2f, float l2b, int tid) {
    const int ch = item >> 2, h = item & 3, r = tid >> 2, qt = tid & 3, row = ch * 128 + r;
    float q[64], o[16];
    { const u32x4v* qp = (const u32x4v*)(P + (size_t)row * INW + C_RQ + h * 64);
#pragma unroll
      for (int i = 0; i < 8; ++i) { const u32x4v w = qp[i]; UNPACK8(q, 8 * i, w); } }
#pragma unroll
    for (int d = 0; d < 16; ++d) o[d] = 0.f;
    for (int j = 0; j < 128; ++j) {
        const u32x4v* kp = (const u32x4v*)(P + (size_t)(ch * 128 + j) * INW + C_RK + h * 64);
        float s = 0.f;
#pragma unroll
        for (int i = 0; i < 8; ++i) { const u32x4v w = kp[i]; float kk[8]; UNPACK8(kk, 0, w);
#pragma unroll
            for (int e = 0; e < 8; ++e) s += q[8 * i + e] * kk[e]; }
        const float w = (r > j) ? exp2f((float)(r - j) * l2f) : ((r < j) ? exp2f((float)(j - r) * l2b) : 2.0f);
        s *= w;
        const u32x4v* vp = (const u32x4v*)(P + (size_t)(ch * 128 + j) * INW + C_RV + h * 64 + qt * 16);
#pragma unroll
        for (int i = 0; i < 2; ++i) { const u32x4v vw = vp[i]; float vv[8]; UNPACK8(vv, 0, vw);
#pragma unroll
            for (int e = 0; e < 8; ++e) o[8 * i + e] += s * vv[e]; }
    }
    { const float qdf = exp2f((float)(r + 1) * l2f), qdb = exp2f((float)(128 - r) * l2b);
      const bf16* Sf = SB + (size_t)(item * 2) * 4096; const bf16* Sb = Sf + 4096;
#pragma unroll 1
      for (int d = 0; d < 16; ++d) { const int dv = qt * 16 + d; const u32x4v* fp = (const u32x4v*)(Sf + dv * 64); const u32x4v* bp = (const u32x4v*)(Sb + dv * 64); float tf = 0.f, tb = 0.f;
#pragma unroll
          for (int i = 0; i < 8; ++i) { const u32x4v wf = fp[i], wb = bp[i]; float ff[8], bb[8]; UNPACK8(ff, 0, wf); UNPACK8(bb, 0, wb);
#pragma unroll
              for (int e = 0; e < 8; ++e) { tf += q[8 * i + e] * ff[e]; tb += q[8 * i + e] * bb[e]; } }
          const float t = qdf * tf + qdb * tb;
#pragma unroll
          for (int dd = 0; dd < 16; ++dd) o[dd] += (dd == d) ? t : 0.f; } }
    float s = 0.f;
#pragma unroll
    for (int d = 0; d < 16; ++d) s += o[d];
    s += __shfl_xor(s, 1); s += __shfl_xor(s, 2);
    const float mu = s * (1.0f / 64.0f); float qq = 0.f;
#pragma unroll
    for (int d = 0; d < 16; ++d) { o[d] -= mu; qq += o[d] * o[d]; }
    qq += __shfl_xor(qq, 1); qq += __shfl_xor(qq, 2);
    const float rstd = 1.0f / sqrtf(qq * (1.0f / 64.0f) + EPS);
    const u32x4v* gp = (const u32x4v*)(P + (size_t)row * INW + C_RG + h * 64 + qt * 16); u32x4v* op = (u32x4v*)(MIX + (size_t)row * DM + h * 64 + qt * 16);
#pragma unroll
    for (int i = 0; i < 2; ++i) { const u32x4v gw = gp[i]; float gg[8]; UNPACK8(gg, 0, gw);
#pragma unroll
        for (int e = 0; e < 8; ++e) gg[e] *= o[8 * i + e] * rstd * norm_g[h * 64 + qt * 16 + 8 * i + e];
        u32x4v w; w.x = pk2(gg[0], gg[1]); w.y = pk2(gg[2], gg[3]); w.z = pk2(gg[4], gg[5]); w.w = pk2(gg[6], gg[7]); op[i] = w; }
}

typedef short bf16x8 __attribute__((ext_vector_type(8)));
typedef short s16x4 __attribute__((ext_vector_type(4)));
__device__ __forceinline__ s16x4 tr16(LAS const unsigned char* p) { return __builtin_bit_cast(s16x4, __builtin_amdgcn_ds_read_tr16_b64_v4i16((LAS s16x4*)p)); }
__device__ __forceinline__ bf16x8 cat8(s16x4 a, s16x4 b) { return (bf16x8){a[0], a[1], a[2], a[3], b[0], b[1], b[2], b[3]}; }
__device__ __forceinline__ bf16x8 pack8(f32x4 a, f32x4 b) { u32x4v w; w[0] = pg8::cvt_pk_bf16(a[0], a[1]); w[1] = pg8::cvt_pk_bf16(a[2], a[3]); w[2] = pg8::cvt_pk_bf16(b[0], b[1]); w[3] = pg8::cvt_pk_bf16(b[2], b[3]); return __builtin_bit_cast(bf16x8, w); }
__device__ __forceinline__ float rows4_max(float x) {
    auto r = __builtin_amdgcn_permlane16_swap(__float_as_uint(x), __float_as_uint(x), false, false); x = fmaxf(__uint_as_float(r[0]), __uint_as_float(r[1]));
    auto q = __builtin_amdgcn_permlane32_swap(__float_as_uint(x), __float_as_uint(x), false, false); return fmaxf(__uint_as_float(q[0]), __uint_as_float(q[1]));
}
__device__ __forceinline__ float rows4_sum(float x) {
    auto r = __builtin_amdgcn_permlane16_swap(__float_as_uint(x), __float_as_uint(x), false, false); x = __uint_as_float(r[0]) + __uint_as_float(r[1]);
    auto q = __builtin_amdgcn_permlane32_swap(__float_as_uint(x), __float_as_uint(x), false, false); return __uint_as_float(q[0]) + __uint_as_float(q[1]);
}
#define MFMA16(a, b, c) __builtin_amdgcn_mfma_f32_16x16x32_bf16(a, b, c, 0, 0, 0)
#define EXP2(x) __builtin_amdgcn_exp2f(x)
constexpr int KVS = 144;
constexpr int KVT = 128 * KVS;
#ifndef PFD
#define PFD 3
#endif

__device__ __forceinline__ void attn_mfma_item(int item, const bf16* P, bf16* MIX, const float* sink, LAS unsigned char* lds, int tid) {
    const int lane = tid & 63, wave = __builtin_amdgcn_readfirstlane(tid >> 6), g = wave >> 1, r0w = 64 * (item & 1) + 32 * (wave & 1);
    const int rb = item >> 2, hk = (item >> 1) & 1, hq = hk * 4 + g, l15 = lane & 15, lg = lane >> 4, q4 = (lane & 15) >> 2, p4 = lane & 3;
    const bool lat = rb < 256; const int bi = rb & 127;
    const int ng = lat ? 5 - (bi == 0 ? 1 : 0) - (bi == 127 ? 1 : 0) : 2;
    const int ctx0 = R_LAT + (lat ? (rb >> 7) : ((rb - 256) >> 1)) * 256;
    bf16x8 qf[2][2];
#pragma unroll
    for (int qt = 0; qt < 2; ++qt)
#pragma unroll
        for (int ks = 0; ks < 2; ++ks) qf[qt][ks] = *(const bf16x8*)(P + (size_t)(rb * 128 + r0w + 16 * qt + l15) * INW + C_AQ + hq * 64 + 32 * ks + 8 * lg);
#pragma unroll
    for (int qt = 0; qt < 2; ++qt)
#pragma unroll
        for (int ks = 0; ks < 2; ++ks) asm volatile("" : "+v"(qf[qt][ks]));
    f32x4 o[4][2];
#pragma unroll
    for (int i = 0; i < 4; ++i)
#pragma unroll
        for (int j = 0; j < 2; ++j) o[i][j] = (f32x4){0.f, 0.f, 0.f, 0.f};
    float m[2]; f32x4 lacc[2];
#pragma unroll
    for (int i = 0; i < 2; ++i) { m[i] = 0.f; lacc[i] = (f32x4){0.f, 0.f, 0.f, 0.f}; }
    bool fresh = true;
    constexpr float DEFER = 8.0f;
    const bf16x8 ones = (bf16x8){0x3F80, 0x3F80, 0x3F80, 0x3F80, 0x3F80, 0x3F80, 0x3F80, 0x3F80};
    const int skey = tid >> 2, spart = tid & 3;
    u32x4v rs[PFD][4];
#define ATT_GID(k) ((lat) ? (((k) + (bi == 0 ? 1 : 0)) + ((bi == 127 && ((k) + (bi == 0 ? 1 : 0)) >= 2) ? 1 : 0)) : (3 + (k)))
#define ATT_ROW0(id) ((id) == 0 ? (rb - 1) * 128 : ((id) == 1 ? rb * 128 : ((id) == 2 ? (rb + 1) * 128 : ctx0 + ((id) - 3) * 128)))
#define ATT_LOAD(k, S) do { const int id_ = ATT_GID(k); const bf16* kp_ = P + (size_t)(ATT_ROW0(id_) + skey) * INW + C_AK + hk * 64 + spart * 16; \
        rs[S][0] = *(const u32x4v*)kp_; rs[S][1] = *(const u32x4v*)(kp_ + 8); rs[S][2] = *(const u32x4v*)(kp_ + (C_AV - C_AK)); rs[S][3] = *(const u32x4v*)(kp_ + (C_AV - C_AK) + 8); } while (0)
#pragma unroll
    for (int k = 0; k < PFD; ++k) if (k < ng) ATT_LOAD(k, k);
#pragma unroll
    for (int k = 0; k < 5; ++k) if (k < ng) {
        LAS unsigned char* Kb = lds + (k & 1) * 2 * KVT; LAS unsigned char* Vb = Kb + KVT;
        { LAS unsigned char* d = Kb + skey * KVS + spart * 32; *(LAS u32x4v*)d = rs[k % PFD][0]; *(LAS u32x4v*)(d + 16) = rs[k % PFD][1]; d += KVT; *(LAS u32x4v*)d = rs[k % PFD][2]; *(LAS u32x4v*)(d + 16) = rs[k % PFD][3]; }
        __syncthreads();
        const int id = ATT_GID(k); const int mode = (id == 0) ? 1 : ((id == 2) ? 2 : 0);
        if (k + PFD < ng) ATT_LOAD(k + PFD, k % PFD);
#pragma unroll 1
        for (int sub = 0; sub < 2; ++sub) {
            if ((mode == 1 && sub == 0 && (item & 1)) || (mode == 2 && sub == 1 && !(item & 1))) continue;
            f32x4 s[4][2];
#pragma unroll
            for (int kt = 0; kt < 4; ++kt) {
                const LAS unsigned char* kr = Kb + (64 * sub + 16 * kt + l15) * KVS + 16 * lg;
                const bf16x8 kf0 = *(const LAS bf16x8*)kr, kf1 = *(const LAS bf16x8*)(kr + 64);
#pragma unroll
                for (int qt = 0; qt < 2; ++qt) { s[kt][qt] = MFMA16(kf0, qf[qt][0], ((f32x4){-m[qt], -m[qt], -m[qt], -m[qt]})); s[kt][qt] = MFMA16(kf1, qf[qt][1], s[kt][qt]); }
            }
            if (mode != 0) {
                const int mb = 64 * sub + 4 * lg - l15 - r0w;
                if (mode == 1) {
#pragma unroll
                    for (int kt = 0; kt < 4; ++kt)
#pragma unroll
                        for (int qt = 0; qt < 2; ++qt)
#pragma unroll
                            for (int r = 0; r < 4; ++r) s[kt][qt][r] = (mb >= -(16 * kt + r - 16 * qt)) ? s[kt][qt][r] : -INFINITY;
                } else {
#pragma unroll
                    for (int kt = 0; kt < 4; ++kt)
#pragma unroll
                        for (int qt = 0; qt < 2; ++qt)
#pragma unroll
                            for (int r = 0; r < 4; ++r) s[kt][qt][r] = (mb <= -(16 * kt + r - 16 * qt)) ? s[kt][qt][r] : -INFINITY;
                }
            }
            float mxq[2];
#pragma unroll
            for (int qt = 0; qt < 2; ++qt) {
                float mx = fmaxf(fmaxf(s[0][qt][0], s[0][qt][1]), fmaxf(s[0][qt][2], s[0][qt][3]));
#pragma unroll
                for (int kt = 1; kt < 4; ++kt) mx = fmaxf(mx, fmaxf(fmaxf(s[kt][qt][0], s[kt][qt][1]), fmaxf(s[kt][qt][2], s[kt][qt][3])));
                mxq[qt] = mx;
            }
            if (fresh || __builtin_amdgcn_ballot_w64(mxq[0] > DEFER || mxq[1] > DEFER) != 0ull) {
                mxq[0] = rows4_max(mxq[0]); mxq[1] = rows4_max(mxq[1]);
#pragma unroll
                for (int qt = 0; qt < 2; ++qt) {
                    const float d = fresh ? fmaxf(mxq[qt], -1e30f) : (mxq[qt] > DEFER ? mxq[qt] : 0.f);
                    m[qt] += d;
                    if (!fresh) { const float al = EXP2(-d); lacc[qt] = lacc[qt] * al;
#pragma unroll
                        for (int dvt = 0; dvt < 4; ++dvt) o[dvt][qt] = o[dvt][qt] * al; }
#pragma unroll
                    for (int kt = 0; kt < 4; ++kt)
#pragma unroll
                        for (int r = 0; r < 4; ++r) s[kt][qt][r] = EXP2(s[kt][qt][r] - d);
                }
            } else {
#pragma unroll
                for (int qt = 0; qt < 2; ++qt)
#pragma unroll
                    for (int kt = 0; kt < 4; ++kt)
#pragma unroll
                        for (int r = 0; r < 4; ++r) s[kt][qt][r] = EXP2(s[kt][qt][r]);
            }
            fresh = false;
#pragma unroll
            for (int ks = 0; ks < 2; ++ks) {
                bf16x8 pf[2];
#pragma unroll
                for (int qt = 0; qt < 2; ++qt) { pf[qt] = pack8(s[2 * ks][qt], s[2 * ks + 1][qt]); lacc[qt] = MFMA16(ones, pf[qt], lacc[qt]); }
#pragma unroll
                for (int dvt = 0; dvt < 4; ++dvt) {
                    const LAS unsigned char* vr = Vb + (64 * sub + 32 * ks + 4 * lg + q4) * KVS + (16 * dvt + 4 * p4) * 2;
                    const bf16x8 vf = cat8(tr16(vr), tr16(vr + 16 * KVS));
#pragma unroll
                    for (int qt = 0; qt < 2; ++qt) o[dvt][qt] = MFMA16(vf, pf[qt], o[dvt][qt]);
                }
            }
        }
    }
#undef ATT_GID
#undef ATT_ROW0
#undef ATT_LOAD
    const float sl = sink[hq] * LOG2E;
#pragma unroll
    for (int qt = 0; qt < 2; ++qt) {
        const float mf = fmaxf(m[qt], sl), al = EXP2(m[qt] - mf), den = lacc[qt][0] * al + EXP2(sl - mf), sc = al / den;
        bf16* op = MIX + (size_t)(rb * 128 + r0w + 16 * qt + l15) * DM + 256 + hq * 64 + 4 * lg;
#pragma unroll
        for (int dvt = 0; dvt < 4; ++dvt) { const f32x4 v = o[dvt][qt] * sc; u32x2v w; w[0] = pg8::cvt_pk_bf16(v[0], v[1]); w[1] = pg8::cvt_pk_bf16(v[2], v[3]); *(u32x2v*)(op + 16 * dvt) = w; }
    }
    __syncthreads();
}

__device__ __forceinline__ void reto_mfma_phase(const bf16* P, const bf16* SB, bf16* MIX, const float* norm_g, const float* decay_f, const float* decay_b, int n_items, int bid, int G, LAS unsigned char* lds, int tid) {
    const int lane = tid & 63, wave = __builtin_amdgcn_readfirstlane(tid >> 6), l15 = lane & 15, lg = lane >> 4, q4 = (lane & 15) >> 2, p4 = lane & 3;
    const int skey = tid >> 2, spart = tid & 3;
    LAS unsigned char* Kb = lds; LAS unsigned char* Vb = lds + KVT;
    u32x4v rs[PFD][4];
#define RO_LOAD(it_, S) do { const bf16* kp_ = P + (size_t)(((it_) >> 2) * 128 + skey) * INW + C_RK + ((it_) & 3) * 64 + spart * 16; \
        rs[S][0] = *(const u32x4v*)kp_; rs[S][1] = *(const u32x4v*)(kp_ + 8); rs[S][2] = *(const u32x4v*)(kp_ + (C_RV - C_RK)); rs[S][3] = *(const u32x4v*)(kp_ + (C_RV - C_RK) + 8); } while (0)
#pragma unroll
    for (int j = 0; j < PFD; ++j) if (bid + j * G < n_items) RO_LOAD(bid + j * G, j);
#pragma unroll
    for (int j = 0; j < 5; ++j) { const int it = bid + j * G; if (it < n_items) {
        const int ch = it >> 2, h = it & 3, i = 16 * wave + l15; const size_t row = (size_t)ch * 128 + i;
        const float df = decay_f[h], db = decay_b[h];
        bf16x8 qf[2], sf[4][2], sb[4][2]; u32x2v gw[4]; f32x4 ng[4];
#pragma unroll
        for (int ks = 0; ks < 2; ++ks) qf[ks] = *(const bf16x8*)(P + row * INW + C_RQ + h * 64 + 32 * ks + 8 * lg);
        { const bf16* Sf = SB + (size_t)(it * 2) * 4096; const bf16* Sb = Sf + 4096;
#pragma unroll
          for (int dvt = 0; dvt < 4; ++dvt)
#pragma unroll
              for (int ks = 0; ks < 2; ++ks) { const int so = (16 * dvt + l15) * 64 + 32 * ks + 8 * lg; sf[dvt][ks] = *(const bf16x8*)(Sf + so); sb[dvt][ks] = *(const bf16x8*)(Sb + so); } }
#pragma unroll
        for (int dvt = 0; dvt < 4; ++dvt) { const int dv0 = h * 64 + 16 * dvt + 4 * lg; gw[dvt] = *(const u32x2v*)(P + row * INW + C_RG + dv0); ng[dvt] = *(const f32x4*)(norm_g + dv0); }
        { LAS unsigned char* d = Kb + skey * KVS + spart * 32; *(LAS u32x4v*)d = rs[j % PFD][0]; *(LAS u32x4v*)(d + 16) = rs[j % PFD][1]; d += KVT; *(LAS u32x4v*)d = rs[j % PFD][2]; *(LAS u32x4v*)(d + 16) = rs[j % PFD][3]; }
        __syncthreads();
        f32x4 o[4], tf[4], tb[4];
#pragma unroll
        for (int d = 0; d < 4; ++d) { o[d] = (f32x4){0.f, 0.f, 0.f, 0.f}; tf[d] = o[d]; tb[d] = o[d]; }
#pragma unroll
        for (int dvt = 0; dvt < 4; ++dvt)
#pragma unroll
            for (int ks = 0; ks < 2; ++ks) { tf[dvt] = MFMA16(sf[dvt][ks], qf[ks], tf[dvt]); tb[dvt] = MFMA16(sb[dvt][ks], qf[ks], tb[dvt]); }
#pragma unroll
        for (int d = 0; d < 4; ++d) asm volatile("" : "+v"(tf[d]), "+v"(tb[d]));
        if (it + PFD * G < n_items) RO_LOAD(it + PFD * G, j % PFD);
        const float l2f = df, l2b = db;
        f32x4 s[8];
#pragma unroll
        for (int jt = 0; jt < 8; ++jt) { const LAS unsigned char* kr = Kb + (16 * jt + l15) * KVS + 16 * lg;
            s[jt] = MFMA16(*(const LAS bf16x8*)kr, qf[0], ((f32x4){0.f, 0.f, 0.f, 0.f})); s[jt] = MFMA16(*(const LAS bf16x8*)(kr + 64), qf[1], s[jt]); }
#pragma unroll
        for (int jt = 0; jt < 8; ++jt)
#pragma unroll
            for (int r = 0; r < 4; ++r) { const int jj = 16 * jt + 4 * lg + r; const int dd = i - jj; const float e = EXP2((float)(dd < 0 ? -dd : dd) * (dd < 0 ? l2b : l2f)); s[jt][r] *= (dd == 0) ? 2.0f : e; }
#pragma unroll
        for (int ks = 0; ks < 4; ++ks) { const bf16x8 pf = pack8(s[2 * ks], s[2 * ks + 1]);
#pragma unroll
            for (int dvt = 0; dvt < 4; ++dvt) { const LAS unsigned char* vr = Vb + (32 * ks + 4 * lg + q4) * KVS + (16 * dvt + 4 * p4) * 2;
                o[dvt] = MFMA16(cat8(tr16(vr), tr16(vr + 16 * KVS)), pf, o[dvt]); } }
        const float qdf = EXP2((float)(i + 1) * l2f), qdb = EXP2((float)(128 - i) * l2b);
        float sum = 0.f;
#pragma unroll
        for (int d = 0; d < 4; ++d) { o[d] = o[d] + tf[d] * qdf + tb[d] * qdb; sum += (o[d][0] + o[d][1]) + (o[d][2] + o[d][3]); }
        sum = rows4_sum(sum);
        const float mu = sum * (1.0f / 64.0f); float qq = 0.f;
#pragma unroll
        for (int d = 0; d < 4; ++d) { o[d] = o[d] - mu; qq += (o[d][0] * o[d][0] + o[d][1] * o[d][1]) + (o[d][2] * o[d][2] + o[d][3] * o[d][3]); }
        qq = rows4_sum(qq);
        const float rstd = __builtin_amdgcn_rsqf(qq * (1.0f / 64.0f) + EPS);
#pragma unroll
        for (int dvt = 0; dvt < 4; ++dvt) { const int dv0 = h * 64 + 16 * dvt + 4 * lg;
            const f32x4 gt = (f32x4){bf_lo(gw[dvt][0]), bf_hi(gw[dvt][0]), bf_lo(gw[dvt][1]), bf_hi(gw[dvt][1])};
            const f32x4 v = o[dvt] * rstd * ng[dvt] * gt; u32x2v w; w[0] = pg8::cvt_pk_bf16(v[0], v[1]); w[1] = pg8::cvt_pk_bf16(v[2], v[3]);
            *(u32x2v*)(MIX + row * DM + dv0) = w; }
        __syncthreads();
    } }
#undef RO_LOAD
}

__device__ __forceinline__ void retd_mfma_phase(const bf16* P, float* DB, const float* decay_f, const float* decay_b, int it0, int n_items, int G, LAS unsigned char* lds, int tid) {
    const int lane = tid & 63, wave = __builtin_amdgcn_readfirstlane(tid >> 6), l15 = lane & 15, lg = lane >> 4, q4 = (lane & 15) >> 2, p4 = lane & 3;
    const int skey = tid >> 2, spart = tid & 3, dir = wave & 1, dvt = wave >> 1;
    u32x4v rk0, rk1, rv0, rv1;
#define RD_LOAD(it_) do { const bf16* kp_ = P + (size_t)(((it_) >> 2) * 128 + skey) * INW + C_RK + ((it_) & 3) * 64 + spart * 16; \
        rk0 = *(const u32x4v*)kp_; rk1 = *(const u32x4v*)(kp_ + 8); rv0 = *(const u32x4v*)(kp_ + (C_RV - C_RK)); rv1 = *(const u32x4v*)(kp_ + (C_RV - C_RK) + 8); } while (0)
    if (it0 < n_items) RD_LOAD(it0);
    for (int it = it0; it < n_items; it += G) {
        const int h = it & 3;
        const float l2f = decay_f[h], l2b = decay_b[h];
        { const float wf = EXP2((float)(127 - skey) * l2f), wb = EXP2((float)skey * l2b);
          float t[16]; UNPACK8(t, 0, rk0); UNPACK8(t, 8, rk1);
          u32x4v a0, a1, b0, b1;
#pragma unroll
          for (int e = 0; e < 4; ++e) { a0[e] = pg8::cvt_pk_bf16(t[2 * e] * wf, t[2 * e + 1] * wf); a1[e] = pg8::cvt_pk_bf16(t[8 + 2 * e] * wf, t[9 + 2 * e] * wf);
              b0[e] = pg8::cvt_pk_bf16(t[2 * e] * wb, t[2 * e + 1] * wb); b1[e] = pg8::cvt_pk_bf16(t[8 + 2 * e] * wb, t[9 + 2 * e] * wb); }
          LAS unsigned char* d = lds + skey * KVS + spart * 32; *(LAS u32x4v*)d = a0; *(LAS u32x4v*)(d + 16) = a1; d += KVT; *(LAS u32x4v*)d = b0; *(LAS u32x4v*)(d + 16) = b1;
          d += KVT; *(LAS u32x4v*)d = rv0; *(LAS u32x4v*)(d + 16) = rv1; }
        __syncthreads();
        if (it + G < n_items) RD_LOAD(it + G);
        f32x4 acc[4];
#pragma unroll
        for (int d = 0; d < 4; ++d) acc[d] = (f32x4){0.f, 0.f, 0.f, 0.f};
        const LAS unsigned char* Kt = lds + dir * KVT; const LAS unsigned char* Vt = lds + 2 * KVT;
#pragma unroll
        for (int ks = 0; ks < 4; ++ks) { const int ro = (32 * ks + 4 * lg + q4) * KVS + 8 * p4;
            const bf16x8 vf = cat8(tr16(Vt + ro + 32 * dvt), tr16(Vt + ro + 32 * dvt + 16 * KVS));
#pragma unroll
            for (int dkt = 0; dkt < 4; ++dkt) acc[dkt] = MFMA16(vf, cat8(tr16(Kt + ro + 32 * dkt), tr16(Kt + ro + 32 * dkt + 16 * KVS)), acc[dkt]); }
        float* Dp = DB + (size_t)(it * 2 + dir) * 4096 + (16 * dvt + 4 * lg) * 64 + l15;
#pragma unroll
        for (int dkt = 0; dkt < 4; ++dkt)
#pragma unroll
            for (int r = 0; r < 4; ++r) Dp[r * 64 + 16 * dkt] = acc[dkt][r];
        __syncthreads();
    }
#undef RD_LOAD
}

__device__ __forceinline__ void gmlp_mfma_item(int ch, const bf16* P, bf16* MIX, const float* norm_g, const bf16* WS, const float* b_s, LAS unsigned char* lds, int tid) {
    const int lane = tid & 63, wave = __builtin_amdgcn_readfirstlane(tid >> 6), l15 = lane & 15, lg = lane >> 4, q4 = (lane & 15) >> 2, p4 = lane & 3;
    const int gW = wave >> 1, p0W = 64 * (wave & 1);
    bf16x8 wfa[4][4];
#pragma unroll
    for (int ks = 0; ks < 4; ++ks)
#pragma unroll
        for (int pt = 0; pt < 4; ++pt) wfa[ks][pt] = *(const bf16x8*)(WS + (size_t)gW * 16384 + (size_t)(p0W + 16 * pt + l15) * 128 + 32 * ks + 8 * lg);
    { const int g = tid >> 7, q = tid & 127; float v[64]; const u32x4v* vp = (const u32x4v*)(P + (size_t)(ch * 128 + q) * INW + C_CV + g * 64);
#pragma unroll
      for (int i = 0; i < 8; ++i) { const u32x4v w = vp[i]; UNPACK8(v, 8 * i, w); }
      float s = 0.f;
#pragma unroll
      for (int d = 0; d < 64; ++d) s += v[d];
      const float mu = s * (1.0f / 64.0f); float qq = 0.f;
#pragma unroll
      for (int d = 0; d < 64; ++d) { v[d] -= mu; qq += v[d] * v[d]; }
      const float rstd = __builtin_amdgcn_rsqf(qq * (1.0f / 64.0f) + EPS);
      LAS unsigned char* dst = lds + g * KVT + q * KVS;
#pragma unroll
      for (int i = 0; i < 8; ++i) { const f32x4 n0 = *(const f32x4*)(norm_g + g * 64 + 8 * i), n1 = *(const f32x4*)(norm_g + g * 64 + 8 * i + 4); u32x4v w;
          w[0] = pg8::cvt_pk_bf16(v[8 * i] * rstd * n0[0], v[8 * i + 1] * rstd * n0[1]); w[1] = pg8::cvt_pk_bf16(v[8 * i + 2] * rstd * n0[2], v[8 * i + 3] * rstd * n0[3]);
          w[2] = pg8::cvt_pk_bf16(v[8 * i + 4] * rstd * n1[0], v[8 * i + 5] * rstd * n1[1]); w[3] = pg8::cvt_pk_bf16(v[8 * i + 6] * rstd * n1[2], v[8 * i + 7] * rstd * n1[3]);
          *(LAS u32x4v*)(dst + 16 * i) = w; } }
    __syncthreads();
    const int g = wave >> 1, p0 = 64 * (wave & 1);
    const LAS unsigned char* Vn = lds + g * KVT; const bf16* W = WS + (size_t)g * 16384;
    f32x4 acc[4][4];
#pragma unroll
    for (int i = 0; i < 4; ++i)
#pragma unroll
        for (int j = 0; j < 4; ++j) acc[i][j] = (f32x4){0.f, 0.f, 0.f, 0.f};
#pragma unroll
    for (int ks = 0; ks < 4; ++ks) {
        bf16x8 wf[4], vf[4];
#pragma unroll
        for (int pt = 0; pt < 4; ++pt) wf[pt] = wfa[ks][pt];
#pragma unroll
        for (int dt = 0; dt < 4; ++dt) { const LAS unsigned char* vr = Vn + (32 * ks + 8 * lg + q4) * KVS + (16 * dt + 4 * p4) * 2; vf[dt] = cat8(tr16(vr), tr16(vr + 4 * KVS)); }
#pragma unroll
        for (int dt = 0; dt < 4; ++dt)
#pragma unroll
            for (int pt = 0; pt < 4; ++pt) acc[dt][pt] = MFMA16(vf[dt], wf[pt], acc[dt][pt]);
    }
#pragma unroll
    for (int pt = 0; pt < 4; ++pt) { const int p = p0 + 16 * pt + l15; const size_t row = (size_t)ch * 128 + p; const float bs = b_s[g * 128 + p];
#pragma unroll
        for (int dt = 0; dt < 4; ++dt) { const int c0 = g * 64 + 16 * dt + 4 * lg; const u32x2v uw = *(const u32x2v*)(P + row * INW + C_CU + c0);
            const f32x4 uu = (f32x4){bf_lo(uw[0]), bf_hi(uw[0]), bf_lo(uw[1]), bf_hi(uw[1])}; const f32x4 v = uu * (acc[dt][pt] + bs);
            u32x2v w; w[0] = pg8::cvt_pk_bf16(v[0], v[1]); w[1] = pg8::cvt_pk_bf16(v[2], v[3]); *(u32x2v*)(MIX + row * DM + 768 + c0) = w; } }
    __syncthreads();
}

template <int MODE> __device__ __forceinline__ void ctx_gemm(const bf16* A  , int K, const bf16* Bt, float* X, const float* Xsrc, const float* gate, float sgn, bf16* H, int bid, int G, LAS unsigned char* lds, int tid) {
    const int lane = tid & 63, wave = __builtin_amdgcn_readfirstlane(tid >> 6), l15 = lane & 15, lg = lane >> 4;
    const int ntile = MODE == 0 ? 256 : 1408, ksz = K >> 3, nks = ksz >> 5;
    for (int tile = bid; tile < ntile; tile += G) {
        int row0, brow[4];
        if (MODE == 0) { row0 = (tile >> 4) * 32; const int n0 = (tile & 15) * 64;
#pragma unroll
            for (int ct = 0; ct < 4; ++ct) brow[ct] = n0 + 16 * ct + l15; }
        else { row0 = (tile / 88) * 32; const int hb = tile % 88, n0 = 256 * (hb >> 2) + 32 * (hb & 3);
#pragma unroll
            for (int ct = 0; ct < 4; ++ct) brow[ct] = n0 + 128 * (ct >> 1) + 16 * (ct & 1) + l15; }
        f32x4 acc[2][4];
#pragma unroll
        for (int i = 0; i < 2; ++i)
#pragma unroll
            for (int j = 0; j < 4; ++j) acc[i][j] = (f32x4){0.f, 0.f, 0.f, 0.f};
        const bf16* ap = A + (size_t)(row0 + l15) * K + wave * ksz + 8 * lg;
        const bf16* bp0 = Bt + (size_t)brow[0] * K + wave * ksz + 8 * lg; const bf16* bp1 = Bt + (size_t)brow[1] * K + wave * ksz + 8 * lg;
        const bf16* bp2 = Bt + (size_t)brow[2] * K + wave * ksz + 8 * lg; const bf16* bp3 = Bt + (size_t)brow[3] * K + wave * ksz + 8 * lg;
#pragma unroll 4
        for (int ks = 0; ks < nks; ++ks) {
            const bf16x8 a0 = *(const bf16x8*)(ap + 32 * ks), a1 = *(const bf16x8*)(ap + (size_t)16 * K + 32 * ks);
            const bf16x8 b0 = *(const bf16x8*)(bp0 + 32 * ks), b1 = *(const bf16x8*)(bp1 + 32 * ks), b2 = *(const bf16x8*)(bp2 + 32 * ks), b3 = *(const bf16x8*)(bp3 + 32 * ks);
            acc[0][0] = MFMA16(b0, a0, acc[0][0]); acc[0][1] = MFMA16(b1, a0, acc[0][1]); acc[0][2] = MFMA16(b2, a0, acc[0][2]); acc[0][3] = MFMA16(b3, a0, acc[0][3]);
            acc[1][0] = MFMA16(b0, a1, acc[1][0]); acc[1][1] = MFMA16(b1, a1, acc[1][1]); acc[1][2] = MFMA16(b2, a1, acc[1][2]); acc[1][3] = MFMA16(b3, a1, acc[1][3]);
        }
        LAS f32x4* red = (LAS f32x4*)lds;
#pragma unroll
        for (int rt = 0; rt < 2; ++rt)
#pragma unroll
            for (int ct = 0; ct < 4; ++ct) red[((wave * 2 + rt) * 4 + ct) * 64 + lane] = acc[rt][ct];
        __syncthreads();
        if (MODE == 0) {
            const int slot = tid >> 6, rt = slot >> 2, ct = slot & 3;
            f32x4 v = red[slot * 64 + lane];
#pragma unroll
            for (int w = 1; w < 8; ++w) v += red[(w * 8 + slot) * 64 + lane];
            const int row = row0 + 16 * rt + l15, col = (tile & 15) * 64 + 16 * ct + 4 * lg;
            f32x4* xp = (f32x4*)(X + (size_t)(R_LAT + row) * DM + col); *xp = *(const f32x4*)(Xsrc + (size_t)row * DM + col) + *(const f32x4*)(gate + col) * v * sgn;
        } else if (tid < 256) {
            const int slot = tid >> 6, rt = slot >> 1, cg = slot & 1;
            f32x4 gv = red[((rt * 4) + cg) * 64 + lane], uv = red[((rt * 4) + cg + 2) * 64 + lane];
#pragma unroll
            for (int w = 1; w < 8; ++w) { gv += red[((w * 2 + rt) * 4 + cg) * 64 + lane]; uv += red[((w * 2 + rt) * 4 + cg + 2) * 64 + lane]; }
            const int hb = tile % 88, row = row0 + 16 * rt + l15, hid = 32 * hb + 16 * cg + 4 * lg;
            f32x4 hv;
#pragma unroll
            for (int j = 0; j < 4; ++j) hv[j] = pg8::silu_f(gv[j]) * uv[j];
            u32x2v w; w[0] = pg8::cvt_pk_bf16(hv[0], hv[1]); w[1] = pg8::cvt_pk_bf16(hv[2], hv[3]);
            *(u32x2v*)(H + (size_t)(R_LAT + row) * FF + hid) = w;
        }
        __syncthreads();
    }
}

#define XB_TMO      128
#define XB_XCNT(j)  (256  + 64 * (j))
#define XB_XSUB(j)  (1280 + 64 * (j))
#define XB_XGEN(j)  (2304 + 64 * (j))
#define XB_TOP      3328
#define XB_TOPGEN   3392
#define XCD_BAR_WORDS 3456
#define XB_SPIN_CAP (1u << 18)

__device__ __forceinline__ unsigned xb_ld(unsigned* p)              { return __hip_atomic_load(p, __ATOMIC_RELAXED, __HIP_MEMORY_SCOPE_AGENT); }
__device__ __forceinline__ unsigned xb_add(unsigned* p, unsigned v) { return __hip_atomic_fetch_add(p, v, __ATOMIC_RELAXED, __HIP_MEMORY_SCOPE_AGENT); }
__device__ __forceinline__ unsigned xb_xcc_id() { return (unsigned)__builtin_amdgcn_s_getreg((3 << 11) | 20) & 0xFu; }
#define XB_SPIN(cond, bar) do { unsigned _sp = 0; while (cond) { __builtin_amdgcn_s_sleep(1); \
    if ((++_sp & 255u) == 0u) { if (xb_ld(&(bar)[XB_TMO])) break; if (_sp > XB_SPIN_CAP) { atomicAdd(&(bar)[XB_TMO], 1u); break; } } } } while (0)

struct XcdBarrier {
    unsigned* bar; unsigned x;
    volatile LAS unsigned* st;
};

__device__ __forceinline__ XcdBarrier xcd_barrier_post(unsigned* bar, volatile LAS unsigned* st) {
    XcdBarrier b; b.bar = bar; b.x = xb_xcc_id(); b.st = st;
    if (threadIdx.x == 0) (void)xb_add(&bar[XB_XCNT(b.x)], 1u);
    return b;
}
__device__ __forceinline__ void xcd_barrier_complete(unsigned* bar, unsigned x, unsigned& nloc, unsigned& nx) {
    const unsigned G = gridDim.x * gridDim.y * gridDim.z;
    unsigned sum, cnt, mine, sp = 0u;
    for (;;) {
        sum = 0u; cnt = 0u; mine = 0u;
#pragma unroll
        for (unsigned j = 0; j < 16; ++j) { const unsigned c = xb_ld(&bar[XB_XCNT(j)]); sum += c; cnt += (c > 0u) ? 1u : 0u; mine = (j == x) ? c : mine; }
        if (sum == G) break;
        __builtin_amdgcn_s_sleep(1);
        if ((++sp & 255u) == 0u) { if (xb_ld(&bar[XB_TMO])) break; if (sp > XB_SPIN_CAP) { atomicAdd(&bar[XB_TMO], 1u); break; } }
    }
    nloc = mine > 0u ? mine : 1u; nx = cnt > 0u ? cnt : 1u;
}

__device__ __forceinline__ void xcd_barrier(const XcdBarrier& b) {
    asm volatile("s_waitcnt vmcnt(0)" ::: "memory");
    __syncthreads();
    if (threadIdx.x == 0) {
        unsigned* bar = b.bar;
        __builtin_amdgcn_s_waitcnt(0);
        unsigned nloc = b.st[0], nx = b.st[1];
        if (nloc == 0u) { xcd_barrier_complete(bar, b.x, nloc, nx); b.st[0] = nloc; b.st[1] = nx; }
        const unsigned old = xb_add(&bar[XB_XSUB(b.x)], 1u);
        const unsigned gen = old / nloc;
        if (old + 1u == (gen + 1u) * nloc) {
            __builtin_amdgcn_fence(__ATOMIC_RELEASE, "agent");
            asm volatile("s_waitcnt vmcnt(0)" ::: "memory");
            const unsigned og = xb_add(&bar[XB_TOP], 1u);
            const unsigned tg = og / nx;
            if (og + 1u == (tg + 1u) * nx) xb_add(&bar[XB_TOPGEN], 1u);
            else XB_SPIN(xb_ld(&bar[XB_TOPGEN]) == tg, bar);
            __builtin_amdgcn_fence(__ATOMIC_ACQUIRE, "agent");
            xb_add(&bar[XB_XGEN(b.x)], 1u);
            asm volatile("s_waitcnt vmcnt(0)" ::: "memory");
        } else {
            XB_SPIN(xb_ld(&bar[XB_XGEN(b.x)]) == gen, bar);
            __builtin_amdgcn_fence(__ATOMIC_ACQUIRE, "agent");
            asm volatile("s_waitcnt vmcnt(0)" ::: "memory");
        }
    }
    __syncthreads();
}

#ifndef EPIRES_ALIGN
#define EPIRES_ALIGN true
#endif
#ifndef REP_MASK
#define REP_MASK 0
#endif
#ifndef SYNC_REP
#define SYNC_REP 1
#endif
#ifndef PHMASK
#define PHMASK 255
#endif
constexpr int N_PHASES = 2 + 9 * DEPTH;
__global__ void __launch_bounds__(NT, 2) fwd_kernel(Args a_unused) {
    extern __shared__ __attribute__((aligned(16))) unsigned char lds_raw[];
    LAS unsigned char* lds = (LAS unsigned char*)lds_raw;
    cg::grid_group grid = cg::this_grid();
    const int G = gridDim.x, bid = blockIdx.x, ngw = G * NWAVES;
    volatile LAS unsigned* MISC = (volatile LAS unsigned*)(lds + 131072);
    if (threadIdx.x < 64) MISC[threadIdx.x] = 0u;
    __syncthreads();
    XcdBarrier xbar = xcd_barrier_post((unsigned*)(a_unused.ws + WS_BAR), MISC + 8);
    const int ph_lo = a_unused.ph_lo, ph_hi = a_unused.ph_hi, rep_mask = a_unused.rep_mask, sync_rep = a_unused.sync_rep;
    int rep = 0;
    for (int ph = ph_lo; ph < ph_hi;) {
        KArgs a = (KArgs)__builtin_amdgcn_kernarg_segment_ptr(); asm volatile("" : "+s"(a));
        unsigned char* ws = a->ws;
        float* MOD = (float*)(ws + WS_MOD); float* ROPE = (float*)(ws + WS_ROPE);
        float* XRES = (float*)(ws + WS_X); bf16* ZM = (bf16*)(ws + WS_ZM); bf16* PH = (bf16*)(ws + WS_PH);
        float* DB = (float*)(ws + WS_D); bf16* SB = (bf16*)(ws + WS_S); float* DEC = (float*)(ws + WS_DEC);
        int tid = threadIdx.x; asm volatile("" : "+v"(tid));
        const int lane = tid & 63, wave = __builtin_amdgcn_readfirstlane(tid >> 6), gw = bid * NWAVES + wave;
        if (ph == 0) {
            for (int i = bid * NT + tid; i < 4096; i += G * NT) { const int pos = i >> 4, j = i & 15; const float inv = exp2f(-(float)j * (13.287712379549449f / 16.0f)); const float ang = (float)pos * inv;
                ROPE[2 * i] = __cosf(ang); ROPE[2 * i + 1] = __sinf(ang); }
            if (bid == 0 && tid < 32) { const int l_ = tid >> 3, d_ = (tid >> 2) & 1, h_ = tid & 3; DEC[tid] = log_sigmoid_f((d_ ? a->ret_decay_b : a->ret_decay_f)[l_ * 4 + h_]) * LOG2E; }
            mod_phase(a, MOD, lds, bid, G, tid);
            __syncthreads();
            convert_weights(a, 0, ws + WS_W0, lds, gw, ngw, wave, lane);
        } else if (ph == N_PHASES - 1) {
            norm_phase<2>(a, XRES, ZM, a->final_norm_g, MOD, R_LAT, gw, ngw, lane);
        } else {
            const int l = (ph - 1) / 9, k = (ph - 1) % 9; const bool last = (l == DEPTH - 1);
            unsigned char* wb = ws + WS_W0 + (size_t)(l & 1) * WBUF_BYTES;
            const float* modl = MOD + (size_t)l * 3 * 6144;
            const int rows_out = last ? R_LAT : R_ALL;
            if (k == 0) {
                if (l == 0) norm_phase<1>(a, XRES, ZM, a->norm1_g, modl, R_ALL, gw, ngw, lane);
                else norm_phase<0>(a, XRES, ZM, a->norm1_g + l * DM, modl, R_ALL, gw, ngw, lane);
            } else if (k == 1 || k == 5 || k == 7 || k == 8) {
                const int gm = (k == 1 || (k == 7 && !last)) ? R_ALL : R_LAT, gn = (k == 1) ? INW : (k == 7 ? GUW : DM), gk = (k == 8) ? FF : DM;
                const bf16* gA = (k == 8) ? PH : ZM;
                const bf16* gB = (const bf16*)(wb + (k == 1 ? WO_IN : (k == 5 ? WO_OUT : (k == 7 ? WO_GU : WO_DN))));
                pg8::Gemm g{gA, gB, gm, gn, gk}; pg8::StaticOrder S; S.init(gm, gn, G, bid);
                pg8::EpiAll E{(k == 1) ? 0 : (k == 7 ? 2 : 1), true, (k == 1 || k == 7) || EPIRES_ALIGN, pg8::EpiIn{PH, ROPE}, pg8::EpiRes{XRES, (l == 0 && k == 5) ? a->x : (const float*)XRES, modl + (k == 5 ? 2 * 1024 : 5 * 1024), (rep == 1) ? -1.0f : 1.0f}, pg8::EpiGU{PH}};
#if PHMASK & 1
                pg8::gemm_phase<pg8::EpiAll, pg8::StaticOrder, true, true>(lds, g, S, E);
#endif
                if (!last && (k == 5 || k == 8)) {
                    ctx_gemm<0>(gA + (size_t)R_LAT * gk, gk, gB, XRES, (l == 0 && k == 5) ? a->ctx : (const float*)(XRES + (size_t)R_LAT * DM), modl + 2 * 6144 + (k == 5 ? 2 * 1024 : 5 * 1024), (rep == 1) ? -1.0f : 1.0f, PH, bid, G, lds, tid);
                }
            } else if (k == 2) {
                const int n_att = last ? 1024 : 1040, n_cm = last ? 256 : 260, n_d = NCHUNK * 4;
                for (int rr = 0; rr < 1 + ((rep_mask >> 10) & 1); ++rr)
                for (int it = bid; it < n_att; it += G) attn_mfma_item(it, PH, ZM, a->attn_sink + l * 8, lds, tid);
                const int o1 = (G - (n_att % G)) % G;
                for (int rr = 0; rr < 1 + ((rep_mask >> 11) & 1); ++rr)
                for (int it = (bid + o1) % G; it < n_cm; it += G) gmlp_mfma_item(it, PH, ZM, a->cm_norm_g + l * 256, (const bf16*)(wb + WO_WS), a->cm_b_s + l * 512, lds, tid);
                const int o2 = (o1 + G - (n_cm % G)) % G;
                for (int rr = 0; rr < 1 + ((rep_mask >> 12) & 1); ++rr)
                retd_mfma_phase(PH, DB, DEC + l * 8, DEC + l * 8 + 4, (bid + o2) % G, n_d, G, lds, tid);
            } else if (k == 3) {
                scan_phase(DB, SB, DEC + l * 8, DEC + l * 8 + 4, bid * NT + tid, G * NT);
                if (!last) { const int w0 = (65536 / NT < G) ? (65536 / NT) * NWAVES : 0;
                    if (gw >= w0) convert_weights(a, l + 1, ws + WS_W0 + (size_t)((l + 1) & 1) * WBUF_BYTES, lds, gw - w0, ngw - w0, wave, lane); }
            } else if (k == 4) {
                reto_mfma_phase(PH, SB, ZM, a->ret_norm_g + l * 256, DEC + l * 8, DEC + l * 8 + 4, (last ? 256 : 260) * 4, bid, G, lds, tid);
            } else if (k == 6) {
                norm_phase<0>(a, XRES, ZM, a->norm2_g + l * DM, modl + 3 * 1024, rows_out, gw, ngw, lane);
            }
        }
        if (ph + 1 < ph_hi) { for (int sr = 0; sr < sync_rep; ++sr) { if (ph_hi > 100000) grid.sync(); else xcd_barrier(xbar); } }
        { const int kk = (ph == 0) ? 9 : (ph - 1) % 9; const int nrep = (ph < N_PHASES - 1 && ((rep_mask >> kk) & 1)) ? ((kk == 5 || kk == 8) ? 3 : 2) : 1;
          if (rep + 1 < nrep) ++rep; else { rep = 0; ++ph; } }
    }
}

#ifndef MK_MULTI
#define MK_MULTI 0
#endif
extern "C" void kernel_launch(void* const* d_in, const int* in_sizes, int n_in, void* d_out, int out_size, void* d_ws, size_t ws_size, hipStream_t stream) {
    static int grid = 0;
    if (grid == 0) {
        if (n_in != 21 || ws_size < WS_END) { fprintf(stderr, "kernel_launch: unexpected n_in %d or ws_size %zu (< %zu)\n", n_in, ws_size, (size_t)WS_END); grid = -1; return; }
        int dev = 0, cus = 0;
        if (hipGetDevice(&dev) != hipSuccess || hipDeviceGetAttribute(&cus, hipDeviceAttributeMultiprocessorCount, dev) != hipSuccess) { grid = -1; return; }
        if (hipFuncSetAttribute((const void*)fwd_kernel, hipFuncAttributeMaxDynamicSharedMemorySize, LDS_BYTES) != hipSuccess) { fprintf(stderr, "kernel_launch: hipFuncSetAttribute failed\n"); grid = -1; return; }
        int per_cu = 0;
        if (hipOccupancyMaxActiveBlocksPerMultiprocessor(&per_cu, (const void*)fwd_kernel, NT, LDS_BYTES) != hipSuccess || per_cu < 1) { fprintf(stderr, "kernel_launch: occupancy query says %d\n", per_cu); per_cu = 1; }
        (void)hipGetLastError();
        grid = cus;
    }
    if (grid < 0) return;
    if (hipMemsetAsync((char*)d_ws + WS_BAR, 0, BAR_ZERO_BYTES, stream) != hipSuccess) { fprintf(stderr, "kernel_launch: memset failed\n"); return; }
    Args a{};
    const float** ap = (const float**)&a;
    for (int i = 0; i < 21; ++i) ap[i] = (const float*)d_in[i];
    a.out = (float*)d_out; a.ws = (unsigned char*)d_ws; a.rep_mask = REP_MASK; a.sync_rep = SYNC_REP;
#if MK_MULTI
    for (int ph = 0; ph < N_PHASES; ++ph) { a.ph_lo = ph; a.ph_hi = ph + 1; hipLaunchKernelGGL(fwd_kernel, dim3(grid), dim3(NT), LDS_BYTES, stream, a); }
#else
    a.ph_lo = 0; a.ph_hi = N_PHASES;
    void* args[] = {&a};
    hipError_t e = hipLaunchCooperativeKernel((const void*)fwd_kernel, dim3(grid), dim3(NT), args, LDS_BYTES, stream);
    if (e != hipSuccess) fprintf(stderr, "cooperative launch failed: %s (grid %d)\n", hipGetErrorString(e), grid);
#endif
}
```

```cpp
#include <hip/hip_runtime.h>
#include <hip/hip_cooperative_groups.h>
#include <cstdio>
#include <cstdint>
namespace cg = cooperative_groups;
namespace pg8 {
#define PG8_LAS __attribute__((address_space(3)))
typedef unsigned short bf16_t;
typedef short bf16x8 __attribute__((ext_vector_type(8)));
typedef float f32x4 __attribute__((ext_vector_type(4)));
typedef unsigned u32x4 __attribute__((ext_vector_type(4)));
constexpr int BM = 256, BK = 64, HALF = 128, HTB = HALF * BK * 2  , STAGE_BYTES = 8 * HTB, NXCD = 8, WGM = 8;

__host__ __device__ __forceinline__ int lds_byte(int r, int c) { const int st = (r >> 4) * 2 + (c >> 5), rr = r & 15, cc = c & 31, ob = rr * 64 + cc * 2; return st * 1024 + (ob ^ (((ob >> 9) & 1) << 5)); }
__host__ __device__ __forceinline__ void stage_rc(int b, int& R, int& C) { const int st = b / 1024, sb = b % 1024, swz = sb ^ (((sb >> 9) & 1) << 5); R = (st >> 1) * 16 + swz / 64; C = (st & 1) * 32 + (swz % 64) / 2; }
__host__ __device__ __forceinline__ int perm32(int rho) { const int n = rho >> 4, i = rho & 15; return 8 * (i >> 2) + 4 * n + (i & 3); }

struct Unit { int pm, pn; };
struct Gemm { const bf16_t* A; const bf16_t* Bt; int M, N, K; };

struct StaticOrder {
    int nM, nN, nwg, G, c;
    __host__ __device__ void init(int M, int N, int G_, int c_) { nM = M / BM; nN = N / BM; nwg = nM * nN; G = G_; c = c_; }
    __host__ __device__ bool next(int i, Unit& u) const {
        const long L = (long)i * G + c; if (L >= nwg) return false;
        int wgid = (int)L; { const int q = nwg / NXCD, r = nwg % NXCD, xcd = wgid % NXCD, off = wgid / NXCD; wgid = (xcd < r ? xcd * (q + 1) : r * (q + 1) + (xcd - r) * q) + off; }
        const int nig = WGM * nN, gid = wgid / nig, fm = gid * WGM, gsz = (nM - fm) < WGM ? (nM - fm) : WGM;
        u.pm = fm + ((wgid % nig) % gsz); u.pn = (wgid % nig) / gsz; return true;
    }
    __device__ __forceinline__ void a_ready(const Unit&) const {}
    __device__ __forceinline__ void done(const Unit&) const {}
};
__device__ __forceinline__ unsigned cvt_pk_bf16(float lo, float hi) { unsigned r; asm volatile("v_cvt_pk_bf16_f32 %0, %1, %2" : "=v"(r) : "v"(lo), "v"(hi)); return r; }
typedef float f32x2 __attribute__((ext_vector_type(2)));
__device__ __forceinline__ float silu_f(float x) { return x * __builtin_amdgcn_rcpf(1.0f + __builtin_amdgcn_exp2f(-1.4426950408889634f * x)); }
__device__ __forceinline__ float gelu_tanh_f(float x) { return x * __builtin_amdgcn_rcpf(1.0f + __builtin_amdgcn_exp2f(-2.3022082f * (x + 0.044715f * x * x * x))); }

struct EpiIn {
    static constexpr bool PERM = true, AFTER_DRAIN = false;
    bf16_t* P; const float* rope;
    __device__ __forceinline__ void operator()(const f32x4 (&acc)[2][2][4][2], const Unit& u, int wr, int wc, int fr, int fq) const {
        const int pn = u.pn; const bool latent = u.pm < 128;
        const int row0 = u.pm * BM + wr * 64 + fr;
        const int half = wc & 1;
        const bool roped = latent && (pn < 2 || (pn >= 4 && pn <= 6));
        float inv[4];
#pragma unroll
        for (int i = 0; i < 4; ++i) inv[i] = exp2f(-(float)(4 * fq + i) * (13.287712379549449f / 16.0f));
#pragma unroll
        for (int ai = 0; ai < 2; ++ai)
#pragma unroll
            for (int m = 0; m < 4; ++m) {
                const int row = row0 + ai * HALF + m * 16;
                const int t = row & 16383; const int pos = half ? (t & 63) : (t >> 6);
                bf16_t* rowp = P + (size_t)row * 2304 + pn * BM + wc * 32 + 8 * fq;
                f32x4 cs0 = (f32x4){1.f, 0.f, 1.f, 0.f}, cs1 = cs0;
                if (roped) { const float p = (float)pos; const float a0 = p * inv[0], a1 = p * inv[1], a2 = p * inv[2], a3 = p * inv[3];
                    cs0 = (f32x4){__cosf(a0), __sinf(a0), __cosf(a1), __sinf(a1)}; cs1 = (f32x4){__cosf(a2), __sinf(a2), __cosf(a3), __sinf(a3)}; }
#pragma unroll
                for (int bj = 0; bj < 2; ++bj) {
                    f32x4 v0 = acc[ai][bj][m][0], v1 = acc[ai][bj][m][1];
                    int kind = 0; float sc = 1.f;
                    if (pn == 0) kind = 1;
                    else if (pn == 1) { kind = 1; sc = 0.125f; }
                    else if (pn == 3) kind = 2;
                    else if (pn == 4 || pn == 5) { kind = 1; sc = 0.125f * 1.4426950408889634f; }
                    else if (pn == 6) kind = (bj == 0) ? 1 : 0;
                    else if (pn >= 7) kind = 3;
                    if (kind == 1) {
                        f32x4 a, b;
                        a[0] = v0[0] * cs0[0] - v0[1] * cs0[1]; a[1] = v0[1] * cs0[0] + v0[0] * cs0[1];
                        a[2] = v0[2] * cs0[2] - v0[3] * cs0[3]; a[3] = v0[3] * cs0[2] + v0[2] * cs0[3];
                        b[0] = v1[0] * cs1[0] - v1[1] * cs1[1]; b[1] = v1[1] * cs1[0] + v1[0] * cs1[1];
                        b[2] = v1[2] * cs1[2] - v1[3] * cs1[3]; b[3] = v1[3] * cs1[2] + v1[2] * cs1[3];
                        v0 = a * sc; v1 = b * sc;
                    } else if (kind == 2) {
#pragma unroll
                        for (int j = 0; j < 4; ++j) { v0[j] = silu_f(v0[j]); v1[j] = silu_f(v1[j]); }
                    } else if (kind == 3) {
#pragma unroll
                        for (int j = 0; j < 4; ++j) { v0[j] = gelu_tanh_f(v0[j]); v1[j] = gelu_tanh_f(v1[j]); }
                    }
                    u32x4 w; w.x = cvt_pk_bf16(v0[0], v0[1]); w.y = cvt_pk_bf16(v0[2], v0[3]); w.z = cvt_pk_bf16(v1[0], v1[1]); w.w = cvt_pk_bf16(v1[2], v1[3]);
                    *(u32x4*)(rowp + bj * HALF) = w;
                }
            }
    }
};
struct EpiRes {
    static constexpr bool PERM = true, AFTER_DRAIN = false;
    float* X; const float* Xsrc; const float* gate0; float sgn;
    __device__ __forceinline__ void operator()(const f32x4 (&acc)[2][2][4][2], const Unit& u, int wr, int wc, int fr, int fq) const {
        const int s = u.pm < 64 ? 0 : (u.pm < 128 ? 1 : 2);
        const float* gv = gate0 + s * 6144;
        const int row0 = u.pm * BM + wr * 64 + fr, col0 = u.pn * BM + wc * 32 + 8 * fq;
        f32x4 g[2][2];
#pragma unroll
        for (int bj = 0; bj < 2; ++bj)
#pragma unroll
            for (int n = 0; n < 2; ++n) g[bj][n] = *(const f32x4*)(gv + col0 + bj * HALF + n * 4) * sgn;
#pragma unroll
        for (int ai = 0; ai < 2; ++ai)
#pragma unroll
            for (int mp = 0; mp < 2; ++mp) {
                f32x4 xv[2][2][2];
#pragma unroll
                for (int mm = 0; mm < 2; ++mm) { const float* rowp = Xsrc + (size_t)(row0 + ai * HALF + (2 * mp + mm) * 16) * 1024 + col0;
#pragma unroll
                    for (int bj = 0; bj < 2; ++bj)
#pragma unroll
                        for (int n = 0; n < 2; ++n) xv[mm][bj][n] = *(const f32x4*)(rowp + bj * HALF + n * 4); }
#pragma unroll
                for (int mm = 0; mm < 2; ++mm) { float* rowp = X + (size_t)(row0 + ai * HALF + (2 * mp + mm) * 16) * 1024 + col0;
#pragma unroll
                    for (int bj = 0; bj < 2; ++bj)
#pragma unroll
                        for (int n = 0; n < 2; ++n) *(f32x4*)(rowp + bj * HALF + n * 4) = xv[mm][bj][n] + g[bj][n] * acc[ai][bj][2 * mp + mm][n]; }
                asm volatile("" ::: "memory");
            }
    }
};
struct EpiGU {
    static constexpr bool PERM = true, AFTER_DRAIN = false;
    bf16_t* H;
    __device__ __forceinline__ void operator()(const f32x4 (&acc)[2][2][4][2], const Unit& u, int wr, int wc, int fr, int fq) const {
        const int row0 = u.pm * BM + wr * 64 + fr, hid0 = u.pn * HALF + wc * 32 + 8 * fq;
#pragma unroll
        for (int ai = 0; ai < 2; ++ai)
#pragma unroll
            for (int m = 0; m < 4; ++m) { bf16_t* rowp = H + (size_t)(row0 + ai * HALF + m * 16) * 2816 + hid0;
                f32x4 g0 = acc[ai][0][m][0], g1 = acc[ai][0][m][1]; const f32x4 u0 = acc[ai][1][m][0], u1 = acc[ai][1][m][1];
#pragma unroll
                for (int j = 0; j < 4; ++j) { g0[j] = silu_f(g0[j]) * u0[j]; g1[j] = silu_f(g1[j]) * u1[j]; }
                u32x4 w; w.x = cvt_pk_bf16(g0[0], g0[1]); w.y = cvt_pk_bf16(g0[2], g0[3]); w.z = cvt_pk_bf16(g1[0], g1[1]); w.w = cvt_pk_bf16(g1[2], g1[3]);
                *(u32x4*)rowp = w; }
    }
};

struct EpiAll {
    static constexpr bool AFTER_DRAIN = false;
    int mode; bool perm, align; EpiIn ein; EpiRes eres; EpiGU egu;
    __device__ __forceinline__ void operator()(const f32x4 (&acc)[2][2][4][2], const Unit& u, int wr, int wc, int fr, int fq) const {
        if (mode == 0) ein(acc, u, wr, wc, fr, fq); else if (mode == 1) eres(acc, u, wr, wc, fr, fq); else egu(acc, u, wr, wc, fr, fq);
    }
};

template <class Epi, class Sched, bool ALIGN_EPI = false, bool SP2 = false>
__device__ __forceinline__ void gemm_phase(PG8_LAS unsigned char* lds, const Gemm g, const Sched& S, const Epi& E) {
    int tid_o = threadIdx.x; asm volatile("" : "+v"(tid_o));
    const int tid = tid_o, wid = __builtin_amdgcn_readfirstlane(tid >> 6), lane = tid & 63, wr = wid >> 2, wc = wid & 3, fr = lane & 15, fq = lane >> 4;
    const int K = g.K, nt = K / BK;
    unsigned voffA[2], voffB[2];
#pragma unroll
    for (int i = 0; i < 2; ++i) { int R, C; stage_rc(tid * 16 + i * 8192, R, C); const int Rb = E.perm ? ((R & ~31) + perm32(R & 31)) : R;
        voffA[i] = (unsigned)(R * K + C) * 2u; voffB[i] = (unsigned)(Rb * K + C) * 2u; }
    const size_t kstep = (size_t)(BK * 2);
    const size_t hstep = (size_t)HALF * K * 2;
    const size_t tstep = 2 * hstep;
    const unsigned ldsw = (unsigned)wid * 1024u;
    const int aoff = lds_byte(wr * 64 + fr, fq * 8), boff = lds_byte(wc * 32 + fr, fq * 8);
#define PG8_SA(b, h) (((b) * 2 + (h)) * HTB)
#define PG8_SB(b, h) ((4 + (b) * 2 + (h)) * HTB)
#define PG8_STAGE(bufoff, gbase, voff) do { _Pragma("unroll") for (int _i = 0; _i < 2; ++_i) \
        __builtin_amdgcn_global_load_lds((const unsigned*)((const char*)(gbase) + (voff)[_i]), (PG8_LAS unsigned*)(lds + (bufoff) + ldsw + _i * 8192), 16, 0, 0); } while (0)
#define PG8_LDA(dst, b, h) do { _Pragma("unroll") for (int m = 0; m < 4; ++m) _Pragma("unroll") for (int k = 0; k < 2; ++k) dst[m][k] = *(const PG8_LAS bf16x8*)(lds + PG8_SA(b, h) + aoff + m * 2048 + k * 1024); } while (0)
#define PG8_LDB(dst, b, h) do { _Pragma("unroll") for (int n = 0; n < 2; ++n) _Pragma("unroll") for (int k = 0; k < 2; ++k) dst[n][k] = *(const PG8_LAS bf16x8*)(lds + PG8_SB(b, h) + boff + n * 2048 + k * 1024); } while (0)
#define PG8_MMA(ai, bj, At, Bt) do { __builtin_amdgcn_s_setprio(1); _Pragma("unroll") for (int m = 0; m < 4; ++m) _Pragma("unroll") for (int n = 0; n < 2; ++n) _Pragma("unroll") for (int k = 0; k < 2; ++k) \
        acc[ai][bj][m][n] = __builtin_amdgcn_mfma_f32_16x16x32_bf16(Bt[n][k], At[m][k], acc[ai][bj][m][n], 0, 0, 0); __builtin_amdgcn_s_setprio(0); } while (0)
#define PG8_WAIT_V(n) asm volatile("s_waitcnt vmcnt(" #n ")" ::: "memory")
#define PG8_WAIT_L(n) asm volatile("s_waitcnt lgkmcnt(" #n ")" ::: "memory")
#define PG8_BAR __builtin_amdgcn_s_barrier()
#define PG8_SCHED __builtin_amdgcn_sched_barrier(0)
    Unit cur, nxt; int ui = 0;
    if (!S.next(0, cur)) return;
    f32x4 acc[2][2][4][2];
#pragma unroll
    for (int a = 0; a < 2; ++a)
#pragma unroll
        for (int b = 0; b < 2; ++b)
#pragma unroll
            for (int m = 0; m < 4; ++m)
#pragma unroll
                for (int n = 0; n < 2; ++n) acc[a][b][m][n] = (f32x4){0.f, 0.f, 0.f, 0.f};
    bf16x8 At[4][2], B0[2][2], B1[2][2];
    const char* cA = (const char*)g.A + (size_t)cur.pm * tstep; const char* cB = (const char*)g.Bt + (size_t)cur.pn * tstep;
    S.a_ready(cur);
    if constexpr (SP2) {
        PG8_STAGE(PG8_SB(0, 0), cB, voffB); PG8_STAGE(PG8_SB(0, 1), cB + hstep, voffB); PG8_STAGE(PG8_SA(0, 0), cA, voffA); PG8_STAGE(PG8_SA(0, 1), cA + hstep, voffA);
        if (wr == 1) PG8_BAR;
        PG8_WAIT_V(2); PG8_BAR;
        PG8_STAGE(PG8_SB(1, 0), cB + kstep, voffB); PG8_STAGE(PG8_SA(1, 0), cA + kstep, voffA); PG8_STAGE(PG8_SB(1, 1), cB + hstep + kstep, voffB);
        PG8_WAIT_V(6); PG8_BAR;
    } else {
        PG8_STAGE(PG8_SB(0, 0), cB, voffB); PG8_STAGE(PG8_SA(0, 0), cA, voffA); PG8_STAGE(PG8_SB(0, 1), cB + hstep, voffB); PG8_STAGE(PG8_SA(0, 1), cA + hstep, voffA);
        if (wr == 1) PG8_BAR;
        PG8_WAIT_V(4); PG8_BAR;
        PG8_STAGE(PG8_SB(1, 0), cB + kstep, voffB); PG8_STAGE(PG8_SA(1, 0), cA + kstep, voffA); PG8_STAGE(PG8_SB(1, 1), cB + hstep + kstep, voffB);
        PG8_WAIT_V(6); PG8_BAR;
    }
    for (;;) {
        const bool has_next = S.next(ui + 1, nxt);
        const char* nA = has_next ? (const char*)g.A + (size_t)nxt.pm * tstep : cA; const char* nB = has_next ? (const char*)g.Bt + (size_t)nxt.pn * tstep : cB;
        for (int t = 0; t < nt; t += 2) {
            const bool last = (t == nt - 2);
            const char* a1 = cA + (size_t)(t + 1) * kstep;
            const char* a2 = last ? nA : cA + (size_t)(t + 2) * kstep; const char* b2 = last ? nB : cB + (size_t)(t + 2) * kstep;
            const char* a3 = a2 + kstep; const char* b3 = b2 + kstep;
            if (last && has_next) S.a_ready(nxt);
            if constexpr (SP2) {
            PG8_LDB(B0, 0, 0); PG8_LDB(B1, 0, 1); PG8_SCHED; PG8_LDA(At, 0, 0); PG8_STAGE(PG8_SA(1, 1), a1 + hstep, voffA);
            PG8_WAIT_V(8); PG8_WAIT_L(0); PG8_BAR; PG8_MMA(0, 0, At, B0); PG8_MMA(0, 1, At, B1); PG8_BAR; PG8_SCHED;
            PG8_LDA(At, 0, 1); PG8_STAGE(PG8_SB(0, 0), b2, voffB); PG8_STAGE(PG8_SB(0, 1), b2 + hstep, voffB); PG8_STAGE(PG8_SA(0, 0), a2, voffA);
            PG8_WAIT_V(8); PG8_WAIT_L(0); PG8_BAR; PG8_MMA(1, 0, At, B0); PG8_MMA(1, 1, At, B1); PG8_BAR; PG8_SCHED;
            PG8_LDB(B0, 1, 0); PG8_LDB(B1, 1, 1); PG8_SCHED; PG8_LDA(At, 1, 0); PG8_STAGE(PG8_SA(0, 1), a2 + hstep, voffA);
            PG8_WAIT_V(8); PG8_WAIT_L(0); PG8_BAR; PG8_MMA(0, 0, At, B0); PG8_MMA(0, 1, At, B1); PG8_BAR; PG8_SCHED;
            PG8_LDA(At, 1, 1); PG8_STAGE(PG8_SB(1, 0), b3, voffB); PG8_STAGE(PG8_SB(1, 1), b3 + hstep, voffB); PG8_STAGE(PG8_SA(1, 0), a3, voffA);
            PG8_WAIT_V(8); PG8_WAIT_L(0); PG8_BAR; PG8_MMA(1, 0, At, B0); PG8_MMA(1, 1, At, B1); PG8_BAR; PG8_SCHED;
            } else {
            PG8_LDB(B0, 0, 0); PG8_SCHED; PG8_LDA(At, 0, 0); PG8_STAGE(PG8_SA(1, 1), a1 + hstep, voffA);
            PG8_WAIT_L(8); PG8_BAR; PG8_WAIT_L(0); PG8_MMA(0, 0, At, B0); PG8_BAR; PG8_SCHED;
            PG8_LDB(B1, 0, 1); PG8_STAGE(PG8_SB(0, 0), b2, voffB);
            PG8_BAR; PG8_WAIT_L(0); PG8_MMA(0, 1, At, B1); PG8_BAR;
            PG8_LDA(At, 0, 1); PG8_STAGE(PG8_SA(0, 0), a2, voffA);
            PG8_BAR; PG8_WAIT_L(0); PG8_MMA(1, 0, At, B0); PG8_BAR; PG8_SCHED;
            PG8_STAGE(PG8_SB(0, 1), b2 + hstep, voffB);
            PG8_WAIT_V(6); PG8_BAR; PG8_MMA(1, 1, At, B1); PG8_BAR;
            PG8_LDB(B0, 1, 0); PG8_SCHED; PG8_LDA(At, 1, 0); PG8_STAGE(PG8_SA(0, 1), a2 + hstep, voffA);
            PG8_WAIT_L(8); PG8_BAR; PG8_WAIT_L(0); PG8_MMA(0, 0, At, B0); PG8_BAR; PG8_SCHED;
            PG8_LDB(B1, 1, 1); PG8_STAGE(PG8_SB(1, 0), b3, voffB);
            PG8_BAR; PG8_WAIT_L(0); PG8_MMA(0, 1, At, B1); PG8_BAR;
            PG8_LDA(At, 1, 1); PG8_STAGE(PG8_SA(1, 0), a3, voffA);
            PG8_BAR; PG8_WAIT_L(0); PG8_MMA(1, 0, At, B0); PG8_BAR; PG8_SCHED;
            PG8_STAGE(PG8_SB(1, 1), b3 + hstep, voffB);
            PG8_WAIT_V(6); PG8_BAR; PG8_MMA(1, 1, At, B1); PG8_BAR;
            }
        }
        if (E.align) { if (wr == 0) PG8_BAR; }
        if constexpr (!Epi::AFTER_DRAIN) { E(acc, cur, wr, wc, fr, fq); S.done(cur); }
        if (!has_next) break;
#pragma unroll
        for (int a = 0; a < 2; ++a)
#pragma unroll
            for (int b = 0; b < 2; ++b)
#pragma unroll
                for (int m = 0; m < 4; ++m)
#pragma unroll
                    for (int n = 0; n < 2; ++n) acc[a][b][m][n] = (f32x4){0.f, 0.f, 0.f, 0.f};
        cur = nxt; cA = nA; cB = nB; ++ui;
        if (E.align) { if (wr == 1) PG8_BAR; }
    }
    PG8_WAIT_V(0);
    if (!E.align) { if (wr == 0) PG8_BAR; }
    PG8_BAR;
    if constexpr (Epi::AFTER_DRAIN) { E.fused(acc, cur, wr, wc, fr, fq, lds, wid, lane); S.done(cur); }
#undef PG8_SA
#undef PG8_SB
#undef PG8_STAGE
#undef PG8_LDA
#undef PG8_LDB
#undef PG8_MMA
#undef PG8_WAIT_V
#undef PG8_WAIT_L
#undef PG8_BAR
#undef PG8_SCHED
}
}

#define LAS __attribute__((address_space(3)))
typedef unsigned short bf16;
typedef float f32x4 __attribute__((ext_vector_type(4)));
typedef unsigned u32x4v __attribute__((ext_vector_type(4)));
typedef unsigned u32x2v __attribute__((ext_vector_type(2)));
constexpr int NWAVES = 8, NT = 512;
constexpr int DM = 1024, SEQ = 16384, R_LAT = 32768, R_CTX = 512, R_ALL = 33280, INW = 2304, FF = 2816, GUW = 5632, DEPTH = 4;
constexpr int C_RQ = 0, C_RK = 256, C_RV = 512, C_RG = 768, C_AQ = 1024, C_AK = 1536, C_AV = 1664, C_CU = 1792, C_CV = 2048;
constexpr int NCHUNK = 260;
constexpr float LOG2E = 1.4426950408889634f;
constexpr float EPS = 1e-6f;
constexpr size_t MiB = 1u << 20;
constexpr size_t WS_BAR = 0, BAR_ZERO_BYTES = 16384;
constexpr size_t WS_MOD = 1 * MiB;
constexpr size_t WS_ROPE = WS_MOD + 512 * 1024;
constexpr size_t WS_DEC = WS_MOD + 768 * 1024;
constexpr size_t WS_W0 = 2 * MiB, WBUF_BYTES = 24 * MiB;
constexpr size_t WO_IN = 0, WO_OUT = (size_t)INW * DM * 2, WO_GU = WO_OUT + (size_t)DM * DM * 2, WO_DN = WO_GU + (size_t)GUW * DM * 2, WO_WS = WO_DN + (size_t)DM * FF * 2, WO_END = WO_WS + 4 * 128 * 128 * 2;
static_assert(WO_END <= WBUF_BYTES, "weight buffer");
constexpr size_t WS_X = WS_W0 + 2 * WBUF_BYTES;
constexpr size_t WS_ZM = WS_X + 130 * MiB;
constexpr size_t WS_PH = WS_ZM + 65 * MiB;
constexpr size_t WS_D = WS_PH + 179 * MiB;
constexpr size_t WS_S = WS_D + 33 * MiB;
constexpr size_t WS_END = WS_S + 17 * MiB;
static_assert((size_t)R_ALL * DM * 4 <= 130 * MiB && (size_t)R_ALL * DM * 2 <= 65 * MiB && (size_t)R_ALL * FF * 2 <= 179 * MiB && (size_t)NCHUNK * 8 * 4096 * 4 <= 33 * MiB, "ws map");
constexpr int LDS_BYTES = 147456;

struct Args {
    const float *x, *c, *ctx, *c_ctx, *w_mod, *b_mod, *norm1_g, *norm2_g, *w_in, *ret_decay_f, *ret_decay_b, *ret_norm_g, *attn_sink, *cm_norm_g, *cm_w_s, *cm_b_s, *w_out, *w_gate, *w_up, *w_down, *final_norm_g;
    float* out; unsigned char* ws; int ph_lo, ph_hi, rep_mask, sync_rep;
};

typedef const __attribute__((address_space(4))) Args* KArgs;

__device__ __forceinline__ float bf_lo(unsigned w) { return __uint_as_float(w << 16); }
__device__ __forceinline__ float bf_hi(unsigned w) { return __uint_as_float(w & 0xffff0000u); }
__device__ __forceinline__ unsigned f2bf(float f) { unsigned u = __float_as_uint(f); return (u + 0x7fffu + ((u >> 16) & 1u)) >> 16; }
__device__ __forceinline__ unsigned pk2(float lo, float hi) { return pg8::cvt_pk_bf16(lo, hi); }
__device__ __forceinline__ float wave_sum(float v) {
#pragma unroll
    for (int o = 1; o < 64; o <<= 1) v += __shfl_xor(v, o);
    return v;
}
__device__ __forceinline__ float log_sigmoid_f(float x) { return -log1pf(expf(-x)); }
#define UNPACK8(dst, off, PW) do { dst[(off) + 0] = bf_lo((PW)[0]); dst[(off) + 1] = bf_hi((PW)[0]); dst[(off) + 2] = bf_lo((PW)[1]); dst[(off) + 3] = bf_hi((PW)[1]); \
    dst[(off) + 4] = bf_lo((PW)[2]); dst[(off) + 5] = bf_hi((PW)[2]); dst[(off) + 6] = bf_lo((PW)[3]); dst[(off) + 7] = bf_hi((PW)[3]); } while (0)

template <int MAP> __device__ __forceinline__ int map_col(int n) {
    if (MAP == 1) { const bool qk = (n < 512) || (n >= 1024 && n < 1664); if (!qk) return n; const int d = n & 63, hf = d >> 5, w = d & 31, j = w & 15, sec = w >> 4; return (n & ~63) + hf * 32 + 2 * j + sec; }
    if (MAP == 2) return 256 * (n >> 7) + (n & 127);
    if (MAP == 3) return 256 * (n >> 7) + 128 + (n & 127);
    return n;
}
template <int MAP> __device__ __forceinline__ void transpose_item(const float* W, int K, int N, bf16* WT, LAS float* scr, int item, int lane) {
    const int nblk = N / 32, kb = item / nblk, nb = item % nblk, k0 = 64 * kb, n0 = 32 * nb;
#pragma unroll 16
    for (int i = 0; i < 32; ++i) { const int kk = 2 * i + (lane >> 5); scr[kk * 33 + (lane & 31)] = W[(size_t)(k0 + kk) * N + n0 + (lane & 31)]; }
    asm volatile("s_waitcnt lgkmcnt(0)" ::: "memory");
    const int c = lane & 7;
#pragma unroll
    for (int j = 0; j < 4; ++j) { const int n = (lane >> 3) + 8 * j; const LAS float* s = scr + (8 * c) * 33 + n;
        u32x4v o; o.x = pk2(s[0 * 33], s[1 * 33]); o.y = pk2(s[2 * 33], s[3 * 33]); o.z = pk2(s[4 * 33], s[5 * 33]); o.w = pk2(s[6 * 33], s[7 * 33]);
        *(u32x4v*)(WT + (size_t)map_col<MAP>(n0 + n) * K + k0 + 8 * c) = o; }
    asm volatile("s_waitcnt lgkmcnt(0)" ::: "memory");
}
__device__ __forceinline__ void convert_weights(KArgs a, int l, unsigned char* wb, LAS unsigned char* lds, int gw, int ngw, int wave, int lane) {
    LAS float* scr = (LAS float*)(lds + wave * 16384);
    constexpr int I_IN = 16 * 72, I_OUT = 16 * 32, I_G = 16 * 88, I_D = 44 * 32, I_WS = 16;
    constexpr int NIT = I_IN + I_OUT + 2 * I_G + I_D + I_WS;
    for (int it = gw; it < NIT; it += ngw) {
        int r = it;
        if (r < I_IN) { transpose_item<1>(a->w_in + (size_t)l * DM * INW, DM, INW, (bf16*)(wb + WO_IN), scr, r, lane); continue; } r -= I_IN;
        if (r < I_OUT) { transpose_item<0>(a->w_out + (size_t)l * DM * DM, DM, DM, (bf16*)(wb + WO_OUT), scr, r, lane); continue; } r -= I_OUT;
        if (r < I_G) { transpose_item<2>(a->w_gate + (size_t)l * DM * FF, DM, FF, (bf16*)(wb + WO_GU), scr, r, lane); continue; } r -= I_G;
        if (r < I_G) { transpose_item<3>(a->w_up + (size_t)l * DM * FF, DM, FF, (bf16*)(wb + WO_GU), scr, r, lane); continue; } r -= I_G;
        if (r < I_D) { transpose_item<0>(a->w_down + (size_t)l * FF * DM, FF, DM, (bf16*)(wb + WO_DN), scr, r, lane); continue; } r -= I_D;
        { const float* src = a->cm_w_s + (size_t)l * 65536 + r * 4096; bf16* dst = (bf16*)(wb + WO_WS) + r * 4096;
            for (int i = lane; i < 1024; i += 64) { const f32x4 v = *(const f32x4*)(src + 4 * i); u32x2v o; o.x = pk2(v[0], v[1]); o.y = pk2(v[2], v[3]); *(u32x2v*)(dst + 4 * i) = o; } }
    }
}
__device__ __forceinline__ void mod_phase(KArgs a, float* MOD, LAS unsigned char* lds, int bid, int G, int tid) {
    LAS float* sc = (LAS float*)lds;
    LAS float* red = (LAS float*)(lds + 16384);
    for (int i = tid; i < 3072; i += NT) { const float v = i < 2048 ? a->c[i] : a->c_ctx[i - 2048]; sc[i] = v / (1.0f + __expf(-v)); }
    __syncthreads();
    const int cx = tid & 31, ks = tid >> 5;
    for (int it = bid; it < 4 * 48; it += G) {
        const int l = it / 48, cb = it % 48;
        const float* W = a->w_mod + (size_t)l * DM * 6144 + cb * 128 + cx * 4;
        f32x4 a0 = {0.f, 0.f, 0.f, 0.f}, a1 = a0, a2 = a0;
#pragma unroll 16
        for (int k = ks * 64; k < ks * 64 + 64; ++k) { const f32x4 w = *(const f32x4*)(W + (size_t)k * 6144); a0 += w * sc[k]; a1 += w * sc[1024 + k]; a2 += w * sc[2048 + k]; }
        *(LAS f32x4*)(red + (ks * 3 + 0) * 128 + cx * 4) = a0; *(LAS f32x4*)(red + (ks * 3 + 1) * 128 + cx * 4) = a1; *(LAS f32x4*)(red + (ks * 3 + 2) * 128 + cx * 4) = a2;
        __syncthreads();
        if (tid < 384) { const int s = tid >> 7, col = tid & 127; float v = a->b_mod[l * 6144 + cb * 128 + col];
#pragma unroll
            for (int k = 0; k < 16; ++k) v += red[(k * 3 + s) * 128 + col];
            MOD[(size_t)(l * 3 + s) * 6144 + cb * 128 + col] = v; }
        __syncthreads();
    }
}
template <int MODE> __device__ __forceinline__ void norm_phase(KArgs a, float* XRES, bf16* ZN, const float* gvec, const float* mod_shift  , int nrows, int gw, int ngw, int lane) {
    f32x4 gm[4], hs[4]; int scur = -1;
#define NIDX(j) (2 * lane + 128 * ((j) >> 1) + ((j) & 1))
    if (MODE == 2) {
#pragma unroll
        for (int j = 0; j < 4; ++j) gm[j] = *((const f32x4*)gvec + NIDX(j)); }
    for (int row = gw; row < nrows; row += ngw) {
        const float* src = (MODE == 1) ? (row < R_LAT ? a->x + (size_t)row * DM : a->ctx + (size_t)(row - R_LAT) * DM) : XRES + (size_t)row * DM;
        const f32x4* xr = (const f32x4*)src;
        f32x4 v[4]; float ss = 0.f;
#pragma unroll
        for (int j = 0; j < 4; ++j) { v[j] = xr[NIDX(j)]; ss += (v[j][0] * v[j][0] + v[j][1] * v[j][1]) + (v[j][2] * v[j][2] + v[j][3] * v[j][3]); }
        if (MODE != 2) { const int s = row < SEQ ? 0 : (row < R_LAT ? 1 : 2);
            if (s != scur) { scur = s; const float* sh = mod_shift + s * 6144; const float* scl = sh + 1024;
#pragma unroll
                for (int j = 0; j < 4; ++j) { gm[j] = *((const f32x4*)gvec + NIDX(j)) * (*((const f32x4*)scl + NIDX(j)) + 1.0f); hs[j] = *((const f32x4*)sh + NIDX(j)); } } }
        const float rstd = __builtin_amdgcn_rsqf(wave_sum(ss) * (1.0f / DM) + EPS);
        if (MODE == 2) { f32x4* o = (f32x4*)(a->out + (size_t)row * DM);
#pragma unroll
            for (int j = 0; j < 4; ++j) o[NIDX(j)] = v[j] * rstd * gm[j]; }
        else { u32x4v* o = (u32x4v*)(ZN + (size_t)row * DM);
#pragma unroll
            for (int h = 0; h < 2; ++h) { const f32x4 z0 = v[2 * h] * rstd * gm[2 * h] + hs[2 * h], z1 = v[2 * h + 1] * rstd * gm[2 * h + 1] + hs[2 * h + 1];
                u32x4v w; w[0] = pk2(z0[0], z0[1]); w[1] = pk2(z0[2], z0[3]); w[2] = pk2(z1[0], z1[1]); w[3] = pk2(z1[2], z1[3]); o[lane + 64 * h] = w; } }
    }
#undef NIDX
}

__device__ __forceinline__ void attn_naive_item(int item, const bf16* P, bf16* MIX, const float* sink, int tid) {
    const int rb = item >> 1, hk = item & 1, g = tid >> 7, r = tid & 127, hq = hk * 4 + g, row = rb * 128 + r;
    float q[64], o[64];
    { const u32x4v* qp = (const u32x4v*)(P + (size_t)row * INW + C_AQ + hq * 64);
#pragma unroll
      for (int i = 0; i < 8; ++i) { const u32x4v w = qp[i]; UNPACK8(q, 8 * i, w); } }
#pragma unroll
    for (int d = 0; d < 64; ++d) o[d] = 0.f;
    float m = -1e30f, lsum = 0.f;
    for (int sg = 0; sg < 4; ++sg) {
        int krow0, nk, mode;
        if (rb < 256) { const int b = rb >> 7, i = rb & 127;
            if (sg == 0) { if (i == 0) continue; krow0 = (rb - 1) * 128; nk = 128; mode = 1; }
            else if (sg == 1) { krow0 = rb * 128; nk = 128; mode = 0; }
            else if (sg == 2) { if (i == 127) continue; krow0 = (rb + 1) * 128; nk = 128; mode = 2; }
            else { krow0 = R_LAT + b * 256; nk = 256; mode = 0; } }
        else { if (sg != 3) continue; const int b = (rb - 256) >> 1; krow0 = R_LAT + b * 256; nk = 256; mode = 0; }
        for (int c = 0; c < nk; ++c) {
            const u32x4v* kp = (const u32x4v*)(P + (size_t)(krow0 + c) * INW + C_AK + hk * 64);
            float s = 0.f;
#pragma unroll
            for (int i = 0; i < 8; ++i) { const u32x4v w = kp[i]; float kk[8]; UNPACK8(kk, 0, w);
#pragma unroll
                for (int e = 0; e < 8; ++e) s += q[8 * i + e] * kk[e]; }
            const bool valid = (mode == 0) || (mode == 1 ? (c >= r) : (c <= r));
            s = valid ? s : -INFINITY;
            const float mn = fmaxf(m, s), al = exp2f(m - mn), p = exp2f(s - mn);
            lsum = lsum * al + p; m = mn;
            const u32x4v* vp = (const u32x4v*)(P + (size_t)(krow0 + c) * INW + C_AV + hk * 64);
#pragma unroll
            for (int i = 0; i < 8; ++i) { const u32x4v w = vp[i]; float vv[8]; UNPACK8(vv, 0, w);
#pragma unroll
                for (int e = 0; e < 8; ++e) o[8 * i + e] = o[8 * i + e] * al + p * vv[e]; }
        }
    }
    { const float sl = sink[hq] * LOG2E, mf = fmaxf(m, sl), al = exp2f(m - mf); lsum = lsum * al + exp2f(sl - mf); const float inv = al / lsum;
      u32x4v* op = (u32x4v*)(MIX + (size_t)row * DM + 256 + hq * 64);
#pragma unroll
      for (int i = 0; i < 8; ++i) { u32x4v w; w.x = pk2(o[8 * i] * inv, o[8 * i + 1] * inv); w.y = pk2(o[8 * i + 2] * inv, o[8 * i + 3] * inv); w.z = pk2(o[8 * i + 4] * inv, o[8 * i + 5] * inv); w.w = pk2(o[8 * i + 6] * inv, o[8 * i + 7] * inv); op[i] = w; } }
}
__device__ __forceinline__ void gmlp_naive_item(int ch, const bf16* P, bf16* MIX, const float* norm_g, const float* w_s, const float* b_s, LAS unsigned char* lds, int tid) {
    LAS float* vn = (LAS float*)lds;
    const int g = tid >> 7, p = tid & 127, row = ch * 128 + p;
    { float v[64]; const u32x4v* vp = (const u32x4v*)(P + (size_t)row * INW + C_CV + g * 64);
#pragma unroll
      for (int i = 0; i < 8; ++i) { const u32x4v w = vp[i]; UNPACK8(v, 8 * i, w); }
      float s = 0.f;
#pragma unroll
      for (int d = 0; d < 64; ++d) s += v[d];
      const float mu = s * (1.0f / 64.0f); float qq = 0.f;
#pragma unroll
      for (int d = 0; d < 64; ++d) { v[d] -= mu; qq += v[d] * v[d]; }
      const float rstd = 1.0f / sqrtf(qq * (1.0f / 64.0f) + EPS);
#pragma unroll
      for (int d = 0; d < 64; ++d) vn[p * 256 + g * 64 + d] = v[d] * rstd * norm_g[g * 64 + d]; }
    __syncthreads();
    float acc[64];
#pragma unroll
    for (int d = 0; d < 64; ++d) acc[d] = 0.f;
    const float* wrow = w_s + (size_t)(g * 128 + p) * 128;
    for (int qi = 0; qi < 128; ++qi) { const float w = wrow[qi]; const LAS f32x4* vr = (const LAS f32x4*)(vn + qi * 256 + g * 64);
#pragma unroll
        for (int i = 0; i < 16; ++i) { const f32x4 x = vr[i]; acc[4 * i] += w * x[0]; acc[4 * i + 1] += w * x[1]; acc[4 * i + 2] += w * x[2]; acc[4 * i + 3] += w * x[3]; } }
    const float bs = b_s[g * 128 + p];
    const u32x4v* up = (const u32x4v*)(P + (size_t)row * INW + C_CU + g * 64); u32x4v* op = (u32x4v*)(MIX + (size_t)row * DM + 768 + g * 64);
#pragma unroll
    for (int i = 0; i < 8; ++i) { const u32x4v w = up[i]; float uu[8]; UNPACK8(uu, 0, w);
#pragma unroll
        for (int e = 0; e < 8; ++e) uu[e] *= (acc[8 * i + e] + bs);
        u32x4v o; o.x = pk2(uu[0], uu[1]); o.y = pk2(uu[2], uu[3]); o.z = pk2(uu[4], uu[5]); o.w = pk2(uu[6], uu[7]); op[i] = o; }
    __syncthreads();
}
__device__ __forceinline__ void retd_naive_item(int item, const bf16* P, float* DB, float l2f, float l2b, LAS unsigned char* lds, int tid) {
    const int ch = item >> 2, h = item & 3;
    LAS float* Ks = (LAS float*)lds; LAS float* Vs = Ks + 8192; LAS float* wf = Vs + 8192; LAS float* wb = wf + 128;
    for (int i = tid; i < 1024; i += NT) { const int j = i >> 3, c8 = (i & 7) * 8; const size_t ro = (size_t)(ch * 128 + j) * INW + h * 64 + c8;
        const u32x4v kw = *(const u32x4v*)(P + ro + C_RK), vw = *(const u32x4v*)(P + ro + C_RV); float t[8];
        UNPACK8(t, 0, kw);
#pragma unroll
        for (int e = 0; e < 8; ++e) Ks[j * 64 + c8 + e] = t[e];
        UNPACK8(t, 0, vw);
#pragma unroll
        for (int e = 0; e < 8; ++e) Vs[j * 64 + c8 + e] = t[e]; }
    if (tid < 128) { wf[tid] = exp2f((float)(127 - tid) * l2f); wb[tid] = exp2f((float)tid * l2b); }
    __syncthreads();
    float* Df = DB + (size_t)(item * 2) * 4096; float* Dbk = Df + 4096;
#pragma unroll 1
    for (int i = 0; i < 8; ++i) { const int e = tid + NT * i, dv = e >> 6, dk = e & 63; float af = 0.f, ab = 0.f;
        for (int j = 0; j < 128; ++j) { const float kv = Ks[j * 64 + dk] * Vs[j * 64 + dv]; af += wf[j] * kv; ab += wb[j] * kv; }
        Df[e] = af; Dbk[e] = ab; }
    __syncthreads();
}
__device__ __forceinline__ void scan_phase(const float* __restrict__ DB, bf16* __restrict__ SB, const float* decay_f, const float* decay_b, int gtid, int gthreads) {
    for (int id = gtid; id < 65536; id += gthreads) {
        const int e = id & 4095, dir = (id >> 12) & 1, h = (id >> 13) & 3, b = id >> 15;
        const float cd = exp2f(128.0f * (dir ? decay_b[h] : decay_f[h]));
        const size_t off = (size_t)(h * 2 + dir) * 4096 + e;
        const int c0 = 256 + 2 * b, c1 = c0 + 1;
        const int first = dir ? c1 : c0, second = dir ? c0 : c1;
        const float d0 = DB[(size_t)first * 32768 + off], d1 = DB[(size_t)second * 32768 + off];
        float s = d0;
        SB[(size_t)first * 32768 + off] = (bf16)0;
        SB[(size_t)second * 32768 + off] = (bf16)f2bf(s); s = s * cd + d1;
#pragma unroll 1
        for (int i0 = 0; i0 < 128; i0 += 32) {
            float d[32];
#pragma unroll
            for (int i = 0; i < 32; ++i) { const int ch = b * 128 + (dir ? 127 - (i0 + i) : (i0 + i)); d[i] = DB[(size_t)ch * 32768 + off]; }
#pragma unroll
            for (int i = 0; i < 32; ++i) { const int ch = b * 128 + (dir ? 127 - (i0 + i) : (i0 + i)); SB[(size_t)ch * 32768 + off] = (bf16)f2bf(s); s = s * cd + d[i]; }
        }
    }
}
__device__ __forceinline__ void reto_naive_item(int item, const bf16* P, const bf16* SB, bf16* MIX, const float* norm_g, float l2f, float l2b, int tid) {
    const int ch = item >> 2, h = item & 3, r = tid >> 2, qt = tid & 3, row = ch * 128 + r;
    float q[64], o[16];
    { const u32x4v* qp = (const u32x4v*)(P + (size_t)row * INW + C_RQ + h * 64);
#pragma unroll
      for (int i = 0; i < 8; ++i) { const u32x4v w = qp[i]; UNPACK8(q, 8 * i, w); } }
#pragma unroll
    for (int d = 0; d < 16; ++d) o[d] = 0.f;
    for (int j = 0; j < 128; ++j) {
        const u32x4v* kp = (const u32x4v*)(P + (size_t)(ch * 128 + j) * INW + C_RK + h * 64);
        float s = 0.f;
#pragma unroll
        for (int i = 0; i < 8; ++i) { const u32x4v w = kp[i]; float kk[8]; UNPACK8(kk, 0, w);
#pragma unroll
            for (int e = 0; e < 8; ++e) s += q[8 * i + e] * kk[e]; }
        const float w = (r > j) ? exp2f((float)(r - j) * l2f) : ((r < j) ? exp2f((float)(j - r) * l2b) : 2.0f);
        s *= w;
        const u32x4v* vp = (const u32x4v*)(P + (size_t)(ch * 128 + j) * INW + C_RV + h * 64 + qt * 16);
#pragma unroll
        for (int i = 0; i < 2; ++i) { const u32x4v vw = vp[i]; float vv[8]; UNPACK8(vv, 0, vw);
#pragma unroll
            for (int e = 0; e < 8; ++e) o[8 * i + e] += s * vv[e]; }
    }
    { const float qdf = exp2f((float)(r + 1) * l2f), qdb = exp2f((float)(128 - r) * l2b);
      const bf16* Sf = SB + (size_t)(item * 2) * 4096; const bf16* Sb = Sf + 4096;
#pragma unroll 1
      for (int d = 0; d < 16; ++d) { const int dv = qt * 16 + d; const u32x4v* fp = (const u32x4v*)(Sf + dv * 64); const u32x4v* bp = (const u32x4v*)(Sb + dv * 64); float tf = 0.f, tb = 0.f;
#pragma unroll
          for (int i = 0; i < 8; ++i) { const u32x4v wf = fp[i], wb = bp[i]; float ff[8], bb[8]; UNPACK8(ff, 0, wf); UNPACK8(bb, 0, wb);
#pragma unroll
              for (int e = 0; e < 8; ++e) { tf += q[8 * i + e] * ff[e]; tb += q[8 * i + e] * bb[e]; } }
          const float t = qdf * tf + qdb * tb;
#pragma unroll
          for (int dd = 0; dd < 16; ++dd) o[dd] += (dd == d) ? t : 0.f; } }
    float s = 0.f;
#pragma unroll
    for (int d = 0; d < 16; ++d) s += o[d];
    s += __shfl_xor(s, 1); s += __shfl_xor(s, 2);
    const float mu = s * (1.0f / 64.0f); float qq = 0.f;
#pragma unroll
    for (int d = 0; d < 16; ++d) { o[d] -= mu; qq += o[d] * o[d]; }
    qq += __shfl_xor(qq, 1); qq += __shfl_xor(qq, 2);
    const float rstd = 1.0f / sqrtf(qq * (1.0f / 64.0f) + EPS);
    const u32x4v* gp = (const u32x4v*)(P + (size_t)row * INW + C_RG + h * 64 + qt * 16); u32x4v* op = (u32x4v*)(MIX + (size_t)row * DM + h * 64 + qt * 16);
#pragma unroll
    for (int i = 0; i < 2; ++i) { const u32x4v gw = gp[i]; float gg[8]; UNPACK8(gg, 0, gw);
#pragma unroll
        for (int e = 0; e < 8; ++e) gg[e] *= o[8 * i + e] * rstd * norm_g[h * 64 + qt * 16 + 8 * i + e];
        u32x4v w; w.x = pk2(gg[0], gg[1]); w.y = pk2(gg[2], gg[3]); w.z = pk2(gg[4], gg[5]); w.w = pk2(gg[6], gg[7]); op[i] = w; }
}

typedef short bf16x8 __attribute__((ext_vector_type(8)));
typedef short s16x4 __attribute__((ext_vector_type(4)));
__device__ __forceinline__ s16x4 tr16(LAS const unsigned char* p) { return __builtin_bit_cast(s16x4, __builtin_amdgcn_ds_read_tr16_b64_v4i16((LAS s16x4*)p)); }
__device__ __forceinline__ bf16x8 cat8(s16x4 a, s16x4 b) { return (bf16x8){a[0], a[1], a[2], a[3], b[0], b[1], b[2], b[3]}; }
__device__ __forceinline__ bf16x8 pack8(f32x4 a, f32x4 b) { u32x4v w; w[0] = pg8::cvt_pk_bf16(a[0], a[1]); w[1] = pg8::cvt_pk_bf16(a[2], a[3]); w[2] = pg8::cvt_pk_bf16(b[0], b[1]); w[3] = pg8::cvt_pk_bf16(b[2], b[3]); return __builtin_bit_cast(bf16x8, w); }
__device__ __forceinline__ float rows4_max(float x) {
    auto r = __builtin_amdgcn_permlane16_swap(__float_as_uint(x), __float_as_uint(x), false, false); x = fmaxf(__uint_as_float(r[0]), __uint_as_float(r[1]));
    auto q = __builtin_amdgcn_permlane32_swap(__float_as_uint(x), __float_as_uint(x), false, false); return fmaxf(__uint_as_float(q[0]), __uint_as_float(q[1]));
}
__device__ __forceinline__ float rows4_sum(float x) {
    auto r = __builtin_amdgcn_permlane16_swap(__float_as_uint(x), __float_as_uint(x), false, false); x = __uint_as_float(r[0]) + __uint_as_float(r[1]);
    auto q = __builtin_amdgcn_permlane32_swap(__float_as_uint(x), __float_as_uint(x), false, false); return __uint_as_float(q[0]) + __uint_as_float(q[1]);
}
#define MFMA16(a, b, c) __builtin_amdgcn_mfma_f32_16x16x32_bf16(a, b, c, 0, 0, 0)
#define EXP2(x) __builtin_amdgcn_exp2f(x)
constexpr int KVS = 144;
constexpr int KVT = 128 * KVS;
#ifndef PFD
#define PFD 3
#endif

__device__ __forceinline__ void attn_mfma_item(int item, const bf16* P, bf16* MIX, const float* sink, LAS unsigned char* lds, int tid) {
    const int lane = tid & 63, wave = __builtin_amdgcn_readfirstlane(tid >> 6), g = wave >> 1, r0w = 64 * (item & 1) + 32 * (wave & 1);
    const int rb = item >> 2, hk = (item >> 1) & 1, hq = hk * 4 + g, l15 = lane & 15, lg = lane >> 4, q4 = (lane & 15) >> 2, p4 = lane & 3;
    const bool lat = rb < 256; const int bi = rb & 127;
    const int ng = lat ? 5 - (bi == 0 ? 1 : 0) - (bi == 127 ? 1 : 0) : 2;
    const int ctx0 = R_LAT + (lat ? (rb >> 7) : ((rb - 256) >> 1)) * 256;
    bf16x8 qf[2][2];
#pragma unroll
    for (int qt = 0; qt < 2; ++qt)
#pragma unroll
        for (int ks = 0; ks < 2; ++ks) qf[qt][ks] = *(const bf16x8*)(P + (size_t)(rb * 128 + r0w + 16 * qt + l15) * INW + C_AQ + hq * 64 + 32 * ks + 8 * lg);
#pragma unroll
    for (int qt = 0; qt < 2; ++qt)
#pragma unroll
        for (int ks = 0; ks < 2; ++ks) asm volatile("" : "+v"(qf[qt][ks]));
    f32x4 o[4][2];
#pragma unroll
    for (int i = 0; i < 4; ++i)
#pragma unroll
        for (int j = 0; j < 2; ++j) o[i][j] = (f32x4){0.f, 0.f, 0.f, 0.f};
    float m[2]; f32x4 lacc[2];
#pragma unroll
    for (int i = 0; i < 2; ++i) { m[i] = 0.f; lacc[i] = (f32x4){0.f, 0.f, 0.f, 0.f}; }
    bool fresh = true;
    constexpr float DEFER = 8.0f;
    const bf16x8 ones = (bf16x8){0x3F80, 0x3F80, 0x3F80, 0x3F80, 0x3F80, 0x3F80, 0x3F80, 0x3F80};
    const int skey = tid >> 2, spart = tid & 3;
    u32x4v rs[PFD][4];
#define ATT_GID(k) ((lat) ? (((k) + (bi == 0 ? 1 : 0)) + ((bi == 127 && ((k) + (bi == 0 ? 1 : 0)) >= 2) ? 1 : 0)) : (3 + (k)))
#define ATT_ROW0(id) ((id) == 0 ? (rb - 1) * 128 : ((id) == 1 ? rb * 128 : ((id) == 2 ? (rb + 1) * 128 : ctx0 + ((id) - 3) * 128)))
#define ATT_LOAD(k, S) do { const int id_ = ATT_GID(k); const bf16* kp_ = P + (size_t)(ATT_ROW0(id_) + skey) * INW + C_AK + hk * 64 + spart * 16; \
        rs[S][0] = *(const u32x4v*)kp_; rs[S][1] = *(const u32x4v*)(kp_ + 8); rs[S][2] = *(const u32x4v*)(kp_ + (C_AV - C_AK)); rs[S][3] = *(const u32x4v*)(kp_ + (C_AV - C_AK) + 8); } while (0)
#pragma unroll
    for (int k = 0; k < PFD; ++k) if (k < ng) ATT_LOAD(k, k);
#pragma unroll
    for (int k = 0; k < 5; ++k) if (k < ng) {
        LAS unsigned char* Kb = lds + (k & 1) * 2 * KVT; LAS unsigned char* Vb = Kb + KVT;
        { LAS unsigned char* d = Kb + skey * KVS + spart * 32; *(LAS u32x4v*)d = rs[k % PFD][0]; *(LAS u32x4v*)(d + 16) = rs[k % PFD][1]; d += KVT; *(LAS u32x4v*)d = rs[k % PFD][2]; *(LAS u32x4v*)(d + 16) = rs[k % PFD][3]; }
        __syncthreads();
        const int id = ATT_GID(k); const int mode = (id == 0) ? 1 : ((id == 2) ? 2 : 0);
        if (k + PFD < ng) ATT_LOAD(k + PFD, k % PFD);
#pragma unroll 1
        for (int sub = 0; sub < 2; ++sub) {
            if ((mode == 1 && sub == 0 && (item & 1)) || (mode == 2 && sub == 1 && !(item & 1))) continue;
            f32x4 s[4][2];
#pragma unroll
            for (int kt = 0; kt < 4; ++kt) {
                const LAS unsigned char* kr = Kb + (64 * sub + 16 * kt + l15) * KVS + 16 * lg;
                const bf16x8 kf0 = *(const LAS bf16x8*)kr, kf1 = *(const LAS bf16x8*)(kr + 64);
#pragma unroll
                for (int qt = 0; qt < 2; ++qt) { s[kt][qt] = MFMA16(kf0, qf[qt][0], ((f32x4){-m[qt], -m[qt], -m[qt], -m[qt]})); s[kt][qt] = MFMA16(kf1, qf[qt][1], s[kt][qt]); }
            }
            if (mode != 0) {
                const int mb = 64 * sub + 4 * lg - l15 - r0w;
                if (mode == 1) {
#pragma unroll
                    for (int kt = 0; kt < 4; ++kt)
#pragma unroll
                        for (int qt = 0; qt < 2; ++qt)
#pragma unroll
                            for (int r = 0; r < 4; ++r) s[kt][qt][r] = (mb >= -(16 * kt + r - 16 * qt)) ? s[kt][qt][r] : -INFINITY;
                } else {
#pragma unroll
                    for (int kt = 0; kt < 4; ++kt)
#pragma unroll
                        for (int qt = 0; qt < 2; ++qt)
#pragma unroll
                            for (int r = 0; r < 4; ++r) s[kt][qt][r] = (mb <= -(16 * kt + r - 16 * qt)) ? s[kt][qt][r] : -INFINITY;
                }
            }
            float mxq[2];
#pragma unroll
            for (int qt = 0; qt < 2; ++qt) {
                float mx = fmaxf(fmaxf(s[0][qt][0], s[0][qt][1]), fmaxf(s[0][qt][2], s[0][qt][3]));
#pragma unroll
                for (int kt = 1; kt < 4; ++kt) mx = fmaxf(mx, fmaxf(fmaxf(s[kt][qt][0], s[kt][qt][1]), fmaxf(s[kt][qt][2], s[kt][qt][3])));
                mxq[qt] = mx;
            }
            if (fresh || __builtin_amdgcn_ballot_w64(mxq[0] > DEFER || mxq[1] > DEFER) != 0ull) {
                mxq[0] = rows4_max(mxq[0]); mxq[1] = rows4_max(mxq[1]);
#pragma unroll
                for (int qt = 0; qt < 2; ++qt) {
                    const float d = fresh ? fmaxf(mxq[qt], -1e30f) : (mxq[qt] > DEFER ? mxq[qt] : 0.f);
                    m[qt] += d;
                    if (!fresh) { const float al = EXP2(-d); lacc[qt] = lacc[qt] * al;
#pragma unroll
                        for (int dvt = 0; dvt < 4; ++dvt) o[dvt][qt] = o[dvt][qt] * al; }
#pragma unroll
                    for (int kt = 0; kt < 4; ++kt)
#pragma unroll
                        for (int r = 0; r < 4; ++r) s[kt][qt][r] = EXP2(s[kt][qt][r] - d);
                }
            } else {
#pragma unroll
                for (int qt = 0; qt < 2; ++qt)
#pragma unroll
                    for (int kt = 0; kt < 4; ++kt)
#pragma unroll
                        for (int r = 0; r < 4; ++r) s[kt][qt][r] = EXP2(s[kt][qt][r]);
            }
            fresh = false;
#pragma unroll
            for (int ks = 0; ks < 2; ++ks) {
                bf16x8 pf[2];
#pragma unroll
                for (int qt = 0; qt < 2; ++qt) { pf[qt] = pack8(s[2 * ks][qt], s[2 * ks + 1][qt]); lacc[qt] = MFMA16(ones, pf[qt], lacc[qt]); }
#pragma unroll
                for (int dvt = 0; dvt < 4; ++dvt) {
                    const LAS unsigned char* vr = Vb + (64 * sub + 32 * ks + 4 * lg + q4) * KVS + (16 * dvt + 4 * p4) * 2;
                    const bf16x8 vf = cat8(tr16(vr), tr16(vr + 16 * KVS));
#pragma unroll
                    for (int qt = 0; qt < 2; ++qt) o[dvt][qt] = MFMA16(vf, pf[qt], o[dvt][qt]);
                }
            }
        }
    }
#undef ATT_GID
#undef ATT_ROW0
#undef ATT_LOAD
    const float sl = sink[hq] * LOG2E;
#pragma unroll
    for (int qt = 0; qt < 2; ++qt) {
        const float mf = fmaxf(m[qt], sl), al = EXP2(m[qt] - mf), den = lacc[qt][0] * al + EXP2(sl - mf), sc = al / den;
        bf16* op = MIX + (size_t)(rb * 128 + r0w + 16 * qt + l15) * DM + 256 + hq * 64 + 4 * lg;
#pragma unroll
        for (int dvt = 0; dvt < 4; ++dvt) { const f32x4 v = o[dvt][qt] * sc; u32x2v w; w[0] = pg8::cvt_pk_bf16(v[0], v[1]); w[1] = pg8::cvt_pk_bf16(v[2], v[3]); *(u32x2v*)(op + 16 * dvt) = w; }
    }
    __syncthreads();
}

__device__ __forceinline__ void reto_mfma_phase(const bf16* P, const bf16* SB, bf16* MIX, const float* norm_g, const float* decay_f, const float* decay_b, int n_items, int bid, int G, LAS unsigned char* lds, int tid) {
    const int lane = tid & 63, wave = __builtin_amdgcn_readfirstlane(tid >> 6), l15 = lane & 15, lg = lane >> 4, q4 = (lane & 15) >> 2, p4 = lane & 3;
    const int skey = tid >> 2, spart = tid & 3;
    LAS unsigned char* Kb = lds; LAS unsigned char* Vb = lds + KVT;
    u32x4v rs[PFD][4];
#define RO_LOAD(it_, S) do { const bf16* kp_ = P + (size_t)(((it_) >> 2) * 128 + skey) * INW + C_RK + ((it_) & 3) * 64 + spart * 16; \
        rs[S][0] = *(const u32x4v*)kp_; rs[S][1] = *(const u32x4v*)(kp_ + 8); rs[S][2] = *(const u32x4v*)(kp_ + (C_RV - C_RK)); rs[S][3] = *(const u32x4v*)(kp_ + (C_RV - C_RK) + 8); } while (0)
#pragma unroll
    for (int j = 0; j < PFD; ++j) if (bid + j * G < n_items) RO_LOAD(bid + j * G, j);
#pragma unroll
    for (int j = 0; j < 5; ++j) { const int it = bid + j * G; if (it < n_items) {
        const int ch = it >> 2, h = it & 3, i = 16 * wave + l15; const size_t row = (size_t)ch * 128 + i;
        const float df = decay_f[h], db = decay_b[h];
        bf16x8 qf[2], sf[4][2], sb[4][2]; u32x2v gw[4]; f32x4 ng[4];
#pragma unroll
        for (int ks = 0; ks < 2; ++ks) qf[ks] = *(const bf16x8*)(P + row * INW + C_RQ + h * 64 + 32 * ks + 8 * lg);
        { const bf16* Sf = SB + (size_t)(it * 2) * 4096; const bf16* Sb = Sf + 4096;
#pragma unroll
          for (int dvt = 0; dvt < 4; ++dvt)
#pragma unroll
              for (int ks = 0; ks < 2; ++ks) { const int so = (16 * dvt + l15) * 64 + 32 * ks + 8 * lg; sf[dvt][ks] = *(const bf16x8*)(Sf + so); sb[dvt][ks] = *(const bf16x8*)(Sb + so); } }
#pragma unroll
        for (int dvt = 0; dvt < 4; ++dvt) { const int dv0 = h * 64 + 16 * dvt + 4 * lg; gw[dvt] = *(const u32x2v*)(P + row * INW + C_RG + dv0); ng[dvt] = *(const f32x4*)(norm_g + dv0); }
        { LAS unsigned char* d = Kb + skey * KVS + spart * 32; *(LAS u32x4v*)d = rs[j % PFD][0]; *(LAS u32x4v*)(d + 16) = rs[j % PFD][1]; d += KVT; *(LAS u32x4v*)d = rs[j % PFD][2]; *(LAS u32x4v*)(d + 16) = rs[j % PFD][3]; }
        __syncthreads();
        f32x4 o[4], tf[4], tb[4];
#pragma unroll
        for (int d = 0; d < 4; ++d) { o[d] = (f32x4){0.f, 0.f, 0.f, 0.f}; tf[d] = o[d]; tb[d] = o[d]; }
#pragma unroll
        for (int dvt = 0; dvt < 4; ++dvt)
#pragma unroll
            for (int ks = 0; ks < 2; ++ks) { tf[dvt] = MFMA16(sf[dvt][ks], qf[ks], tf[dvt]); tb[dvt] = MFMA16(sb[dvt][ks], qf[ks], tb[dvt]); }
#pragma unroll
        for (int d = 0; d < 4; ++d) asm volatile("" : "+v"(tf[d]), "+v"(tb[d]));
        if (it + PFD * G < n_items) RO_LOAD(it + PFD * G, j % PFD);
        const float l2f = df, l2b = db;
        f32x4 s[8];
#pragma unroll
        for (int jt = 0; jt < 8; ++jt) { const LAS unsigned char* kr = Kb + (16 * jt + l15) * KVS + 16 * lg;
            s[jt] = MFMA16(*(const LAS bf16x8*)kr, qf[0], ((f32x4){0.f, 0.f, 0.f, 0.f})); s[jt] = MFMA16(*(const LAS bf16x8*)(kr + 64), qf[1], s[jt]); }
#pragma unroll
        for (int jt = 0; jt < 8; ++jt)
#pragma unroll
            for (int r = 0; r < 4; ++r) { const int jj = 16 * jt + 4 * lg + r; const int dd = i - jj; const float e = EXP2((float)(dd < 0 ? -dd : dd) * (dd < 0 ? l2b : l2f)); s[jt][r] *= (dd == 0) ? 2.0f : e; }
#pragma unroll
        for (int ks = 0; ks < 4; ++ks) { const bf16x8 pf = pack8(s[2 * ks], s[2 * ks + 1]);
#pragma unroll
            for (int dvt = 0; dvt < 4; ++dvt) { const LAS unsigned char* vr = Vb + (32 * ks + 4 * lg + q4) * KVS + (16 * dvt + 4 * p4) * 2;
                o[dvt] = MFMA16(cat8(tr16(vr), tr16(vr + 16 * KVS)), pf, o[dvt]); } }
        const float qdf = EXP2((float)(i + 1) * l2f), qdb = EXP2((float)(128 - i) * l2b);
        float sum = 0.f;
#pragma unroll
        for (int d = 0; d < 4; ++d) { o[d] = o[d] + tf[d] * qdf + tb[d] * qdb; sum += (o[d][0] + o[d][1]) + (o[d][2] + o[d][3]); }
        sum = rows4_sum(sum);
        const float mu = sum * (1.0f / 64.0f); float qq = 0.f;
#pragma unroll
        for (int d = 0; d < 4; ++d) { o[d] = o[d] - mu; qq += (o[d][0] * o[d][0] + o[d][1] * o[d][1]) + (o[d][2] * o[d][2] + o[d][3] * o[d][3]); }
        qq = rows4_sum(qq);
        const float rstd = __builtin_amdgcn_rsqf(qq * (1.0f / 64.0f) + EPS);
#pragma unroll
        for (int dvt = 0; dvt < 4; ++dvt) { const int dv0 = h * 64 + 16 * dvt + 4 * lg;
            const f32x4 gt = (f32x4){bf_lo(gw[dvt][0]), bf_hi(gw[dvt][0]), bf_lo(gw[dvt][1]), bf_hi(gw[dvt][1])};
            const f32x4 v = o[dvt] * rstd * ng[dvt] * gt; u32x2v w; w[0] = pg8::cvt_pk_bf16(v[0], v[1]); w[1] = pg8::cvt_pk_bf16(v[2], v[3]);
            *(u32x2v*)(MIX + row * DM + dv0) = w; }
        __syncthreads();
    } }
#undef RO_LOAD
}

__device__ __forceinline__ void retd_mfma_phase(const bf16* P, float* DB, const float* decay_f, const float* decay_b, int it0, int n_items, int G, LAS unsigned char* lds, int tid) {
    const int lane = tid & 63, wave = __builtin_amdgcn_readfirstlane(tid >> 6), l15 = lane & 15, lg = lane >> 4, q4 = (lane & 15) >> 2, p4 = lane & 3;
    const int skey = tid >> 2, spart = tid & 3, dir = wave & 1, dvt = wave >> 1;
    u32x4v rk0, rk1, rv0, rv1;
#define RD_LOAD(it_) do { const bf16* kp_ = P + (size_t)(((it_) >> 2) * 128 + skey) * INW + C_RK + ((it_) & 3) * 64 + spart * 16; \
        rk0 = *(const u32x4v*)kp_; rk1 = *(const u32x4v*)(kp_ + 8); rv0 = *(const u32x4v*)(kp_ + (C_RV - C_RK)); rv1 = *(const u32x4v*)(kp_ + (C_RV - C_RK) + 8); } while (0)
    if (it0 < n_items) RD_LOAD(it0);
    for (int it = it0; it < n_items; it += G) {
        const int h = it & 3;
        const float l2f = decay_f[h], l2b = decay_b[h];
        { const float wf = EXP2((float)(127 - skey) * l2f), wb = EXP2((float)skey * l2b);
          float t[16]; UNPACK8(t, 0, rk0); UNPACK8(t, 8, rk1);
          u32x4v a0, a1, b0, b1;
#pragma unroll
          for (int e = 0; e < 4; ++e) { a0[e] = pg8::cvt_pk_bf16(t[2 * e] * wf, t[2 * e + 1] * wf); a1[e] = pg8::cvt_pk_bf16(t[8 + 2 * e] * wf, t[9 + 2 * e] * wf);
              b0[e] = pg8::cvt_pk_bf16(t[2 * e] * wb, t[2 * e + 1] * wb); b1[e] = pg8::cvt_pk_bf16(t[8 + 2 * e] * wb, t[9 + 2 * e] * wb); }
          LAS unsigned char* d = lds + skey * KVS + spart * 32; *(LAS u32x4v*)d = a0; *(LAS u32x4v*)(d + 16) = a1; d += KVT; *(LAS u32x4v*)d = b0; *(LAS u32x4v*)(d + 16) = b1;
          d += KVT; *(LAS u32x4v*)d = rv0; *(LAS u32x4v*)(d + 16) = rv1; }
        __syncthreads();
        if (it + G < n_items) RD_LOAD(it + G);
        f32x4 acc[4];
#pragma unroll
        for (int d = 0; d < 4; ++d) acc[d] = (f32x4){0.f, 0.f, 0.f, 0.f};
        const LAS unsigned char* Kt = lds + dir * KVT; const LAS unsigned char* Vt = lds + 2 * KVT;
#pragma unroll
        for (int ks = 0; ks < 4; ++ks) { const int ro = (32 * ks + 4 * lg + q4) * KVS + 8 * p4;
            const bf16x8 vf = cat8(tr16(Vt + ro + 32 * dvt), tr16(Vt + ro + 32 * dvt + 16 * KVS));
#pragma unroll
            for (int dkt = 0; dkt < 4; ++dkt) acc[dkt] = MFMA16(vf, cat8(tr16(Kt + ro + 32 * dkt), tr16(Kt + ro + 32 * dkt + 16 * KVS)), acc[dkt]); }
        float* Dp = DB + (size_t)(it * 2 + dir) * 4096 + (16 * dvt + 4 * lg) * 64 + l15;
#pragma unroll
        for (int dkt = 0; dkt < 4; ++dkt)
#pragma unroll
            for (int r = 0; r < 4; ++r) Dp[r * 64 + 16 * dkt] = acc[dkt][r];
        __syncthreads();
    }
#undef RD_LOAD
}

__device__ __forceinline__ void gmlp_mfma_item(int ch, const bf16* P, bf16* MIX, const float* norm_g, const bf16* WS, const float* b_s, LAS unsigned char* lds, int tid) {
    const int lane = tid & 63, wave = __builtin_amdgcn_readfirstlane(tid >> 6), l15 = lane & 15, lg = lane >> 4, q4 = (lane & 15) >> 2, p4 = lane & 3;
    const int gW = wave >> 1, p0W = 64 * (wave & 1);
    bf16x8 wfa[4][4];
#pragma unroll
    for (int ks = 0; ks < 4; ++ks)
#pragma unroll
        for (int pt = 0; pt < 4; ++pt) wfa[ks][pt] = *(const bf16x8*)(WS + (size_t)gW * 16384 + (size_t)(p0W + 16 * pt + l15) * 128 + 32 * ks + 8 * lg);
    { const int g = tid >> 7, q = tid & 127; float v[64]; const u32x4v* vp = (const u32x4v*)(P + (size_t)(ch * 128 + q) * INW + C_CV + g * 64);
#pragma unroll
      for (int i = 0; i < 8; ++i) { const u32x4v w = vp[i]; UNPACK8(v, 8 * i, w); }
      float s = 0.f;
#pragma unroll
      for (int d = 0; d < 64; ++d) s += v[d];
      const float mu = s * (1.0f / 64.0f); float qq = 0.f;
#pragma unroll
      for (int d = 0; d < 64; ++d) { v[d] -= mu; qq += v[d] * v[d]; }
      const float rstd = __builtin_amdgcn_rsqf(qq * (1.0f / 64.0f) + EPS);
      LAS unsigned char* dst = lds + g * KVT + q * KVS;
#pragma unroll
      for (int i = 0; i < 8; ++i) { const f32x4 n0 = *(const f32x4*)(norm_g + g * 64 + 8 * i), n1 = *(const f32x4*)(norm_g + g * 64 + 8 * i + 4); u32x4v w;
          w[0] = pg8::cvt_pk_bf16(v[8 * i] * rstd * n0[0], v[8 * i + 1] * rstd * n0[1]); w[1] = pg8::cvt_pk_bf16(v[8 * i + 2] * rstd * n0[2], v[8 * i + 3] * rstd * n0[3]);
          w[2] = pg8::cvt_pk_bf16(v[8 * i + 4] * rstd * n1[0], v[8 * i + 5] * rstd * n1[1]); w[3] = pg8::cvt_pk_bf16(v[8 * i + 6] * rstd * n1[2], v[8 * i + 7] * rstd * n1[3]);
          *(LAS u32x4v*)(dst + 16 * i) = w; } }
    __syncthreads();
    const int g = wave >> 1, p0 = 64 * (wave & 1);
    const LAS unsigned char* Vn = lds + g * KVT; const bf16* W = WS + (size_t)g * 16384;
    f32x4 acc[4][4];
#pragma unroll
    for (int i = 0; i < 4; ++i)
#pragma unroll
        for (int j = 0; j < 4; ++j) acc[i][j] = (f32x4){0.f, 0.f, 0.f, 0.f};
#pragma unroll
    for (int ks = 0; ks < 4; ++ks) {
        bf16x8 wf[4], vf[4];
#pragma unroll
        for (int pt = 0; pt < 4; ++pt) wf[pt] = wfa[ks][pt];
#pragma unroll
        for (int dt = 0; dt < 4; ++dt) { const LAS unsigned char* vr = Vn + (32 * ks + 8 * lg + q4) * KVS + (16 * dt + 4 * p4) * 2; vf[dt] = cat8(tr16(vr), tr16(vr + 4 * KVS)); }
#pragma unroll
        for (int dt = 0; dt < 4; ++dt)
#pragma unroll
            for (int pt = 0; pt < 4; ++pt) acc[dt][pt] = MFMA16(vf[dt], wf[pt], acc[dt][pt]);
    }
#pragma unroll
    for (int pt = 0; pt < 4; ++pt) { const int p = p0 + 16 * pt + l15; const size_t row = (size_t)ch * 128 + p; const float bs = b_s[g * 128 + p];
#pragma unroll
        for (int dt = 0; dt < 4; ++dt) { const int c0 = g * 64 + 16 * dt + 4 * lg; const u32x2v uw = *(const u32x2v*)(P + row * INW + C_CU + c0);
            const f32x4 uu = (f32x4){bf_lo(uw[0]), bf_hi(uw[0]), bf_lo(uw[1]), bf_hi(uw[1])}; const f32x4 v = uu * (acc[dt][pt] + bs);
            u32x2v w; w[0] = pg8::cvt_pk_bf16(v[0], v[1]); w[1] = pg8::cvt_pk_bf16(v[2], v[3]); *(u32x2v*)(MIX + row * DM + 768 + c0) = w; } }
    __syncthreads();
}

template <int MODE> __device__ __forceinline__ void ctx_gemm(const bf16* A  , int K, const bf16* Bt, float* X, const float* Xsrc, const float* gate, float sgn, bf16* H, int bid, int G, LAS unsigned char* lds, int tid) {
    const int lane = tid & 63, wave = __builtin_amdgcn_readfirstlane(tid >> 6), l15 = lane & 15, lg = lane >> 4;
    const int ntile = MODE == 0 ? 256 : 1408, ksz = K >> 3, nks = ksz >> 5;
    for (int tile = bid; tile < ntile; tile += G) {
        int row0, brow[4];
        if (MODE == 0) { row0 = (tile >> 4) * 32; const int n0 = (tile & 15) * 64;
#pragma unroll
            for (int ct = 0; ct < 4; ++ct) brow[ct] = n0 + 16 * ct + l15; }
        else { row0 = (tile / 88) * 32; const int hb = tile % 88, n0 = 256 * (hb >> 2) + 32 * (hb & 3);
#pragma unroll
            for (int ct = 0; ct < 4; ++ct) brow[ct] = n0 + 128 * (ct >> 1) + 16 * (ct & 1) + l15; }
        f32x4 acc[2][4];
#pragma unroll
        for (int i = 0; i < 2; ++i)
#pragma unroll
            for (int j = 0; j < 4; ++j) acc[i][j] = (f32x4){0.f, 0.f, 0.f, 0.f};
        const bf16* ap = A + (size_t)(row0 + l15) * K + wave * ksz + 8 * lg;
        const bf16* bp0 = Bt + (size_t)brow[0] * K + wave * ksz + 8 * lg; const bf16* bp1 = Bt + (size_t)brow[1] * K + wave * ksz + 8 * lg;
        const bf16* bp2 = Bt + (size_t)brow[2] * K + wave * ksz + 8 * lg; const bf16* bp3 = Bt + (size_t)brow[3] * K + wave * ksz + 8 * lg;
#pragma unroll 4
        for (int ks = 0; ks < nks; ++ks) {
            const bf16x8 a0 = *(const bf16x8*)(ap + 32 * ks), a1 = *(const bf16x8*)(ap + (size_t)16 * K + 32 * ks);
            const bf16x8 b0 = *(const bf16x8*)(bp0 + 32 * ks), b1 = *(const bf16x8*)(bp1 + 32 * ks), b2 = *(const bf16x8*)(bp2 + 32 * ks), b3 = *(const bf16x8*)(bp3 + 32 * ks);
            acc[0][0] = MFMA16(b0, a0, acc[0][0]); acc[0][1] = MFMA16(b1, a0, acc[0][1]); acc[0][2] = MFMA16(b2, a0, acc[0][2]); acc[0][3] = MFMA16(b3, a0, acc[0][3]);
            acc[1][0] = MFMA16(b0, a1, acc[1][0]); acc[1][1] = MFMA16(b1, a1, acc[1][1]); acc[1][2] = MFMA16(b2, a1, acc[1][2]); acc[1][3] = MFMA16(b3, a1, acc[1][3]);
        }
        LAS f32x4* red = (LAS f32x4*)lds;
#pragma unroll
        for (int rt = 0; rt < 2; ++rt)
#pragma unroll
            for (int ct = 0; ct < 4; ++ct) red[((wave * 2 + rt) * 4 + ct) * 64 + lane] = acc[rt][ct];
        __syncthreads();
        if (MODE == 0) {
            const int slot = tid >> 6, rt = slot >> 2, ct = slot & 3;
            f32x4 v = red[slot * 64 + lane];
#pragma unroll
            for (int w = 1; w < 8; ++w) v += red[(w * 8 + slot) * 64 + lane];
            const int row = row0 + 16 * rt + l15, col = (tile & 15) * 64 + 16 * ct + 4 * lg;
            f32x4* xp = (f32x4*)(X + (size_t)(R_LAT + row) * DM + col); *xp = *(const f32x4*)(Xsrc + (size_t)row * DM + col) + *(const f32x4*)(gate + col) * v * sgn;
        } else if (tid < 256) {
            const int slot = tid >> 6, rt = slot >> 1, cg = slot & 1;
            f32x4 gv = red[((rt * 4) + cg) * 64 + lane], uv = red[((rt * 4) + cg + 2) * 64 + lane];
#pragma unroll
            for (int w = 1; w < 8; ++w) { gv += red[((w * 2 + rt) * 4 + cg) * 64 + lane]; uv += red[((w * 2 + rt) * 4 + cg + 2) * 64 + lane]; }
            const int hb = tile % 88, row = row0 + 16 * rt + l15, hid = 32 * hb + 16 * cg + 4 * lg;
            f32x4 hv;
#pragma unroll
            for (int j = 0; j < 4; ++j) hv[j] = pg8::silu_f(gv[j]) * uv[j];
            u32x2v w; w[0] = pg8::cvt_pk_bf16(hv[0], hv[1]); w[1] = pg8::cvt_pk_bf16(hv[2], hv[3]);
            *(u32x2v*)(H + (size_t)(R_LAT + row) * FF + hid) = w;
        }
        __syncthreads();
    }
}

#define XB_TMO      128
#define XB_XCNT(j)  (256  + 64 * (j))
#define XB_XSUB(j)  (1280 + 64 * (j))
#define XB_XGEN(j)  (2304 + 64 * (j))
#define XB_TOP      3328
#define XB_TOPGEN   3392
#define XCD_BAR_WORDS 3456
#define XB_SPIN_CAP (1u << 18)

__device__ __forceinline__ unsigned xb_ld(unsigned* p)              { return __hip_atomic_load(p, __ATOMIC_RELAXED, __HIP_MEMORY_SCOPE_AGENT); }
__device__ __forceinline__ unsigned xb_add(unsigned* p, unsigned v) { return __hip_atomic_fetch_add(p, v, __ATOMIC_RELAXED, __HIP_MEMORY_SCOPE_AGENT); }
__device__ __forceinline__ unsigned xb_xcc_id() { return (unsigned)__builtin_amdgcn_s_getreg((3 << 11) | 20) & 0xFu; }
#define XB_SPIN(cond, bar) do { unsigned _sp = 0; while (cond) { __builtin_amdgcn_s_sleep(1); \
    if ((++_sp & 255u) == 0u) { if (xb_ld(&(bar)[XB_TMO])) break; if (_sp > XB_SPIN_CAP) { atomicAdd(&(bar)[XB_TMO], 1u); break; } } } } while (0)

struct XcdBarrier {
    unsigned* bar; unsigned x;
    volatile LAS unsigned* st;
};

__device__ __forceinline__ XcdBarrier xcd_barrier_post(unsigned* bar, volatile LAS unsigned* st) {
    XcdBarrier b; b.bar = bar; b.x = xb_xcc_id(); b.st = st;
    if (threadIdx.x == 0) (void)xb_add(&bar[XB_XCNT(b.x)], 1u);
    return b;
}
__device__ __forceinline__ void xcd_barrier_complete(unsigned* bar, unsigned x, unsigned& nloc, unsigned& nx) {
    const unsigned G = gridDim.x * gridDim.y * gridDim.z;
    unsigned sum, cnt, mine, sp = 0u;
    for (;;) {
        sum = 0u; cnt = 0u; mine = 0u;
#pragma unroll
        for (unsigned j = 0; j < 16; ++j) { const unsigned c = xb_ld(&bar[XB_XCNT(j)]); sum += c; cnt += (c > 0u) ? 1u : 0u; mine = (j == x) ? c : mine; }
        if (sum == G) break;
        __builtin_amdgcn_s_sleep(1);
        if ((++sp & 255u) == 0u) { if (xb_ld(&bar[XB_TMO])) break; if (sp > XB_SPIN_CAP) { atomicAdd(&bar[XB_TMO], 1u); break; } }
    }
    nloc = mine > 0u ? mine : 1u; nx = cnt > 0u ? cnt : 1u;
}

__device__ __forceinline__ void xcd_barrier(const XcdBarrier& b) {
    asm volatile("s_waitcnt vmcnt(0)" ::: "memory");
    __syncthreads();
    if (threadIdx.x == 0) {
        unsigned* bar = b.bar;
        __builtin_amdgcn_s_waitcnt(0);
        unsigned nloc = b.st[0], nx = b.st[1];
        if (nloc == 0u) { xcd_barrier_complete(bar, b.x, nloc, nx); b.st[0] = nloc; b.st[1] = nx; }
        const unsigned old = xb_add(&bar[XB_XSUB(b.x)], 1u);
        const unsigned gen = old / nloc;
        if (old + 1u == (gen + 1u) * nloc) {
            __builtin_amdgcn_fence(__ATOMIC_RELEASE, "agent");
            asm volatile("s_waitcnt vmcnt(0)" ::: "memory");
            const unsigned og = xb_add(&bar[XB_TOP], 1u);
            const unsigned tg = og / nx;
            if (og + 1u == (tg + 1u) * nx) xb_add(&bar[XB_TOPGEN], 1u);
            else XB_SPIN(xb_ld(&bar[XB_TOPGEN]) == tg, bar);
            __builtin_amdgcn_fence(__ATOMIC_ACQUIRE, "agent");
            xb_add(&bar[XB_XGEN(b.x)], 1u);
            asm volatile("s_waitcnt vmcnt(0)" ::: "memory");
        } else {
            XB_SPIN(xb_ld(&bar[XB_XGEN(b.x)]) == gen, bar);
            __builtin_amdgcn_fence(__ATOMIC_ACQUIRE, "agent");
            asm volatile("s_waitcnt vmcnt(0)" ::: "memory");
        }
    }
    __syncthreads();
}

#ifndef EPIRES_ALIGN
#define EPIRES_ALIGN true
#endif
#ifndef REP_MASK
#define REP_MASK 0
#endif
#ifndef SYNC_REP
#define SYNC_REP 1
#endif
#ifndef PHMASK
#define PHMASK 255
#endif
constexpr int N_PHASES = 2 + 9 * DEPTH;
__global__ void __launch_bounds__(NT, 2) fwd_kernel(Args a_unused) {
    extern __shared__ __attribute__((aligned(16))) unsigned char lds_raw[];
    LAS unsigned char* lds = (LAS unsigned char*)lds_raw;
    cg::grid_group grid = cg::this_grid();
    const int G = gridDim.x, bid = blockIdx.x, ngw = G * NWAVES;
    volatile LAS unsigned* MISC = (volatile LAS unsigned*)(lds + 131072);
    if (threadIdx.x < 64) MISC[threadIdx.x] = 0u;
    __syncthreads();
    XcdBarrier xbar = xcd_barrier_post((unsigned*)(a_unused.ws + WS_BAR), MISC + 8);
    const int ph_lo = a_unused.ph_lo, ph_hi = a_unused.ph_hi, rep_mask = a_unused.rep_mask, sync_rep = a_unused.sync_rep;
    int rep = 0;
    for (int ph = ph_lo; ph < ph_hi;) {
        KArgs a = (KArgs)__builtin_amdgcn_kernarg_segment_ptr(); asm volatile("" : "+s"(a));
        unsigned char* ws = a->ws;
        float* MOD = (float*)(ws + WS_MOD); float* ROPE = (float*)(ws + WS_ROPE);
        float* XRES = (float*)(ws + WS_X); bf16* ZM = (bf16*)(ws + WS_ZM); bf16* PH = (bf16*)(ws + WS_PH);
        float* DB = (float*)(ws + WS_D); bf16* SB = (bf16*)(ws + WS_S); float* DEC = (float*)(ws + WS_DEC);
        int tid = threadIdx.x; asm volatile("" : "+v"(tid));
        const int lane = tid & 63, wave = __builtin_amdgcn_readfirstlane(tid >> 6), gw = bid * NWAVES + wave;
        if (ph == 0) {
            for (int i = bid * NT + tid; i < 4096; i += G * NT) { const int pos = i >> 4, j = i & 15; const float inv = exp2f(-(float)j * (13.287712379549449f / 16.0f)); const float ang = (float)pos * inv;
                ROPE[2 * i] = __cosf(ang); ROPE[2 * i + 1] = __sinf(ang); }
            if (bid == 0 && tid < 32) { const int l_ = tid >> 3, d_ = (tid >> 2) & 1, h_ = tid & 3; DEC[tid] = log_sigmoid_f((d_ ? a->ret_decay_b : a->ret_decay_f)[l_ * 4 + h_]) * LOG2E; }
            mod_phase(a, MOD, lds, bid, G, tid);
            __syncthreads();
            convert_weights(a, 0, ws + WS_W0, lds, gw, ngw, wave, lane);
        } else if (ph == N_PHASES - 1) {
            norm_phase<2>(a, XRES, ZM, a->final_norm_g, MOD, R_LAT, gw, ngw, lane);
        } else {
            const int l = (ph - 1) / 9, k = (ph - 1) % 9; const bool last = (l == DEPTH - 1);
            unsigned char* wb = ws + WS_W0 + (size_t)(l & 1) * WBUF_BYTES;
            const float* modl = MOD + (size_t)l * 3 * 6144;
            const int rows_out = last ? R_LAT : R_ALL;
            if (k == 0) {
                if (l == 0) norm_phase<1>(a, XRES, ZM, a->norm1_g, modl, R_ALL, gw, ngw, lane);
                else norm_phase<0>(a, XRES, ZM, a->norm1_g + l * DM, modl, R_ALL, gw, ngw, lane);
            } else if (k == 1 || k == 5 || k == 7 || k == 8) {
                const int gm = (k == 1 || (k == 7 && !last)) ? R_ALL : R_LAT, gn = (k == 1) ? INW : (k == 7 ? GUW : DM), gk = (k == 8) ? FF : DM;
                const bf16* gA = (k == 8) ? PH : ZM;
                const bf16* gB = (const bf16*)(wb + (k == 1 ? WO_IN : (k == 5 ? WO_OUT : (k == 7 ? WO_GU : WO_DN))));
                pg8::Gemm g{gA, gB, gm, gn, gk}; pg8::StaticOrder S; S.init(gm, gn, G, bid);
                pg8::EpiAll E{(k == 1) ? 0 : (k == 7 ? 2 : 1), true, (k == 1 || k == 7) || EPIRES_ALIGN, pg8::EpiIn{PH, ROPE}, pg8::EpiRes{XRES, (l == 0 && k == 5) ? a->x : (const float*)XRES, modl + (k == 5 ? 2 * 1024 : 5 * 1024), (rep == 1) ? -1.0f : 1.0f}, pg8::EpiGU{PH}};
#if PHMASK & 1
                pg8::gemm_phase<pg8::EpiAll, pg8::StaticOrder, true, true>(lds, g, S, E);
#endif
                if (!last && (k == 5 || k == 8)) {
                    ctx_gemm<0>(gA + (size_t)R_LAT * gk, gk, gB, XRES, (l == 0 && k == 5) ? a->ctx : (const float*)(XRES + (size_t)R_LAT * DM), modl + 2 * 6144 + (k == 5 ? 2 * 1024 : 5 * 1024), (rep == 1) ? -1.0f : 1.0f, PH, bid, G, lds, tid);
                }
            } else if (k == 2) {
                const int n_att = last ? 1024 : 1040, n_cm = last ? 256 : 260, n_d = NCHUNK * 4;
                for (int rr = 0; rr < 1 + ((rep_mask >> 10) & 1); ++rr)
                for (int it = bid; it < n_att; it += G) attn_mfma_item(it, PH, ZM, a->attn_sink + l * 8, lds, tid);
                const int o1 = (G - (n_att % G)) % G;
                for (int rr = 0; rr < 1 + ((rep_mask >> 11) & 1); ++rr)
                for (int it = (bid + o1) % G; it < n_cm; it += G) gmlp_mfma_item(it, PH, ZM, a->cm_norm_g + l * 256, (const bf16*)(wb + WO_WS), a->cm_b_s + l * 512, lds, tid);
                const int o2 = (o1 + G - (n_cm % G)) % G;
                for (int rr = 0; rr < 1 + ((rep_mask >> 12) & 1); ++rr)
                retd_mfma_phase(PH, DB, DEC + l * 8, DEC + l * 8 + 4, (bid + o2) % G, n_d, G, lds, tid);
            } else if (k == 3) {
                scan_phase(DB, SB, DEC + l * 8, DEC + l * 8 + 4, bid * NT + tid, G * NT);
                if (!last) { const int w0 = (65536 / NT < G) ? (65536 / NT) * NWAVES : 0;
                    if (gw >= w0) convert_weights(a, l + 1, ws + WS_W0 + (size_t)((l + 1) & 1) * WBUF_BYTES, lds, gw - w0, ngw - w0, wave, lane); }
            } else if (k == 4) {
                reto_mfma_phase(PH, SB, ZM, a->ret_norm_g + l * 256, DEC + l * 8, DEC + l * 8 + 4, (last ? 256 : 260) * 4, bid, G, lds, tid);
            } else if (k == 6) {
                norm_phase<0>(a, XRES, ZM, a->norm2_g + l * DM, modl + 3 * 1024, rows_out, gw, ngw, lane);
            }
        }
        if (ph + 1 < ph_hi) { for (int sr = 0; sr < sync_rep; ++sr) { if (ph_hi > 100000) grid.sync(); else xcd_barrier(xbar); } }
        { const int kk = (ph == 0) ? 9 : (ph - 1) % 9; const int nrep = (ph < N_PHASES - 1 && ((rep_mask >> kk) & 1)) ? ((kk == 5 || kk == 8) ? 3 : 2) : 1;
          if (rep + 1 < nrep) ++rep; else { rep = 0; ++ph; } }
    }
}

#ifndef MK_MULTI
#define MK_MULTI 0
#endif
extern "C" void kernel_launch(void* const* d_in, const int* in_sizes, int n_in, void* d_out, int out_size, void* d_ws, size_t ws_size, hipStream_t stream) {
    static int grid = 0;
    if (grid == 0) {
        if (n_in != 21 || ws_size < WS_END) { fprintf(stderr, "kernel_launch: unexpected n_in %d or ws_size %zu (< %zu)\n", n_in, ws_size, (size_t)WS_END); grid = -1; return; }
        int dev = 0, cus = 0;
        if (hipGetDevice(&dev) != hipSuccess || hipDeviceGetAttribute(&cus, hipDeviceAttributeMultiprocessorCount, dev) != hipSuccess) { grid = -1; return; }
        if (hipFuncSetAttribute((const void*)fwd_kernel, hipFuncAttributeMaxDynamicSharedMemorySize, LDS_BYTES) != hipSuccess) { fprintf(stderr, "kernel_launch: hipFuncSetAttribute failed\n"); grid = -1; return; }
        int per_cu = 0;
        if (hipOccupancyMaxActiveBlocksPerMultiprocessor(&per_cu, (const void*)fwd_kernel, NT, LDS_BYTES) != hipSuccess || per_cu < 1) { fprintf(stderr, "kernel_launch: occupancy query says %d\n", per_cu); per_cu = 1; }
        (void)hipGetLastError();
        grid = cus;
    }
    if (grid < 0) return;
    if (hipMemsetAsync((char*)d_ws + WS_BAR, 0, BAR_ZERO_BYTES, stream) != hipSuccess) { fprintf(stderr, "kernel_launch: memset failed\n"); return; }
    Args a{};
    const float** ap = (const float**)&a;
    for (int i = 0; i < 21; ++i) ap[i] = (const float*)d_in[i];
    a.out = (float*)d_out; a.ws = (unsigned char*)d_ws; a.rep_mask = REP_MASK; a.sync_rep = SYNC_REP;
#if MK_MULTI
    for (int ph = 0; ph < N_PHASES; ++ph) { a.ph_lo = ph; a.ph_hi = ph + 1; hipLaunchKernelGGL(fwd_kernel, dim3(grid), dim3(NT), LDS_BYTES, stream, a); }
#else
    a.ph_lo = 0; a.ph_hi = N_PHASES;
    void* args[] = {&a};
    hipError_t e = hipLaunchCooperativeKernel((const void*)fwd_kernel, dim3(grid), dim3(NT), args, LDS_BYTES, stream);
    if (e != hipSuccess) fprintf(stderr, "cooperative launch failed: %s (grid %d)\n", hipGetErrorString(e), grid);
#endif
}
```

```cpp
#include <hip/hip_runtime.h>
#include <hip/hip_cooperative_groups.h>
#include <cstdio>
#include <cstdint>
namespace cg = cooperative_groups;
namespace pg8 {
#define PG8_LAS __attribute__((address_space(3)))
typedef unsigned short bf16_t;
typedef short bf16x8 __attribute__((ext_vector_type(8)));
typedef float f32x4 __attribute__((ext_vector_type(4)));
typedef unsigned u32x4 __attribute__((ext_vector_type(4)));
constexpr int BM = 256, BK = 64, HALF = 128, HTB = HALF * BK * 2  , STAGE_BYTES = 8 * HTB, NXCD = 8, WGM = 8;

__host__ __device__ __forceinline__ int lds_byte(int r, int c) { const int st = (r >> 4) * 2 + (c >> 5), rr = r & 15, cc = c & 31, ob = rr * 64 + cc * 2; return st * 1024 + (ob ^ (((ob >> 9) & 1) << 5)); }
__host__ __device__ __forceinline__ void stage_rc(int b, int& R, int& C) { const int st = b / 1024, sb = b % 1024, swz = sb ^ (((sb >> 9) & 1) << 5); R = (st >> 1) * 16 + swz / 64; C = (st & 1) * 32 + (swz % 64) / 2; }
__host__ __device__ __forceinline__ int perm32(int rho) { const int n = rho >> 4, i = rho & 15; return 8 * (i >> 2) + 4 * n + (i & 3); }

struct Unit { int pm, pn; };
struct Gemm { const bf16_t* A; const bf16_t* Bt; int M, N, K; };

struct StaticOrder {
    int nM, nN, nwg, G, c;
    __host__ __device__ void init(int M, int N, int G_, int c_) { nM = M / BM; nN = N / BM; nwg = nM * nN; G = G_; c = c_; }
    __host__ __device__ bool next(int i, Unit& u) const {
        const long L = (long)i * G + c; if (L >= nwg) return false;
        int wgid = (int)L; { const int q = nwg / NXCD, r = nwg % NXCD, xcd = wgid % NXCD, off = wgid / NXCD; wgid = (xcd < r ? xcd * (q + 1) : r * (q + 1) + (xcd - r) * q) + off; }
        const int nig = WGM * nN, gid = wgid / nig, fm = gid * WGM, gsz = (nM - fm) < WGM ? (nM - fm) : WGM;
        u.pm = fm + ((wgid % nig) % gsz); u.pn = (wgid % nig) / gsz; return true;
    }
    __device__ __forceinline__ void a_ready(const Unit&) const {}
    __device__ __forceinline__ void done(const Unit&) const {}
};
__device__ __forceinline__ unsigned cvt_pk_bf16(float lo, float hi) { unsigned r; asm volatile("v_cvt_pk_bf16_f32 %0, %1, %2" : "=v"(r) : "v"(lo), "v"(hi)); return r; }
typedef float f32x2 __attribute__((ext_vector_type(2)));
__device__ __forceinline__ float silu_f(float x) { return x * __builtin_amdgcn_rcpf(1.0f + __builtin_amdgcn_exp2f(-1.4426950408889634f * x)); }
__device__ __forceinline__ float gelu_tanh_f(float x) { return x * __builtin_amdgcn_rcpf(1.0f + __builtin_amdgcn_exp2f(-2.3022082f * (x + 0.044715f * x * x * x))); }

struct EpiIn {
    static constexpr bool PERM = true, AFTER_DRAIN = false;
    bf16_t* P; const float* rope;
    __device__ __forceinline__ void operator()(const f32x4 (&acc)[2][2][4][2], const Unit& u, int wr, int wc, int fr, int fq) const {
        const int pn = u.pn; const bool latent = u.pm < 128;
        const int row0 = u.pm * BM + wr * 64 + fr;
        const int half = wc & 1;
        const bool roped = latent && (pn < 2 || (pn >= 4 && pn <= 6));
        float inv[4];
#pragma unroll
        for (int i = 0; i < 4; ++i) inv[i] = exp2f(-(float)(4 * fq + i) * (13.287712379549449f / 16.0f));
#pragma unroll
        for (int ai = 0; ai < 2; ++ai)
#pragma unroll
            for (int m = 0; m < 4; ++m) {
                const int row = row0 + ai * HALF + m * 16;
                const int t = row & 16383; const int pos = half ? (t & 63) : (t >> 6);
                bf16_t* rowp = P + (size_t)row * 2304 + pn * BM + wc * 32 + 8 * fq;
                f32x4 cs0 = (f32x4){1.f, 0.f, 1.f, 0.f}, cs1 = cs0;
                if (roped) { const float p = (float)pos; const float a0 = p * inv[0], a1 = p * inv[1], a2 = p * inv[2], a3 = p * inv[3];
                    cs0 = (f32x4){__cosf(a0), __sinf(a0), __cosf(a1), __sinf(a1)}; cs1 = (f32x4){__cosf(a2), __sinf(a2), __cosf(a3), __sinf(a3)}; }
#pragma unroll
                for (int bj = 0; bj < 2; ++bj) {
                    f32x4 v0 = acc[ai][bj][m][0], v1 = acc[ai][bj][m][1];
                    int kind = 0; float sc = 1.f;
                    if (pn == 0) kind = 1;
                    else if (pn == 1) { kind = 1; sc = 0.125f; }
                    else if (pn == 3) kind = 2;
                    else if (pn == 4 || pn == 5) { kind = 1; sc = 0.125f * 1.4426950408889634f; }
                    else if (pn == 6) kind = (bj == 0) ? 1 : 0;
                    else if (pn >= 7) kind = 3;
                    if (kind == 1) {
                        f32x4 a, b;
                        a[0] = v0[0] * cs0[0] - v0[1] * cs0[1]; a[1] = v0[1] * cs0[0] + v0[0] * cs0[1];
                        a[2] = v0[2] * cs0[2] - v0[3] * cs0[3]; a[3] = v0[3] * cs0[2] + v0[2] * cs0[3];
                        b[0] = v1[0] * cs1[0] - v1[1] * cs1[1]; b[1] = v1[1] * cs1[0] + v1[0] * cs1[1];
                        b[2] = v1[2] * cs1[2] - v1[3] * cs1[3]; b[3] = v1[3] * cs1[2] + v1[2] * cs1[3];
                        v0 = a * sc; v1 = b * sc;
                    } else if (kind == 2) {
#pragma unroll
                        for (int j = 0; j < 4; ++j) { v0[j] = silu_f(v0[j]); v1[j] = silu_f(v1[j]); }
                    } else if (kind == 3) {
#pragma unroll
                        for (int j = 0; j < 4; ++j) { v0[j] = gelu_tanh_f(v0[j]); v1[j] = gelu_tanh_f(v1[j]); }
                    }
                    u32x4 w; w.x = cvt_pk_bf16(v0[0], v0[1]); w.y = cvt_pk_bf16(v0[2], v0[3]); w.z = cvt_pk_bf16(v1[0], v1[1]); w.w = cvt_pk_bf16(v1[2], v1[3]);
                    *(u32x4*)(rowp + bj * HALF) = w;
                }
            }
    }
};
struct EpiRes {
    static constexpr bool PERM = true, AFTER_DRAIN = false;
    float* X; const float* Xsrc; const float* gate0; float sgn;
    __device__ __forceinline__ void operator()(const f32x4 (&acc)[2][2][4][2], const Unit& u, int wr, int wc, int fr, int fq) const {
        const int s = u.pm < 64 ? 0 : (u.pm < 128 ? 1 : 2);
        const float* gv = gate0 + s * 6144;
        const int row0 = u.pm * BM + wr * 64 + fr, col0 = u.pn * BM + wc * 32 + 8 * fq;
        f32x4 g[2][2];
#pragma unroll
        for (int bj = 0; bj < 2; ++bj)
#pragma unroll
            for (int n = 0; n < 2; ++n) g[bj][n] = *(const f32x4*)(gv + col0 + bj * HALF + n * 4) * sgn;
#pragma unroll
        for (int ai = 0; ai < 2; ++ai)
#pragma unroll
            for (int mp = 0; mp < 2; ++mp) {
                f32x4 xv[2][2][2];
#pragma unroll
                for (int mm = 0; mm < 2; ++mm) { const float* rowp = Xsrc + (size_t)(row0 + ai * HALF + (2 * mp + mm) * 16) * 1024 + col0;
#pragma unroll
                    for (int bj = 0; bj < 2; ++bj)
#pragma unroll
                        for (int n = 0; n < 2; ++n) xv[mm][bj][n] = *(const f32x4*)(rowp + bj * HALF + n * 4); }
#pragma unroll
                for (int mm = 0; mm < 2; ++mm) { float* rowp = X + (size_t)(row0 + ai * HALF + (2 * mp + mm) * 16) * 1024 + col0;
#pragma unroll
                    for (int bj = 0; bj < 2; ++bj)
#pragma unroll
                        for (int n = 0; n < 2; ++n) *(f32x4*)(rowp + bj * HALF + n * 4) = xv[mm][bj][n] + g[bj][n] * acc[ai][bj][2 * mp + mm][n]; }
                asm volatile("" ::: "memory");
            }
    }
};
struct EpiGU {
    static constexpr bool PERM = true, AFTER_DRAIN = false;
    bf16_t* H;
    __device__ __forceinline__ void operator()(const f32x4 (&acc)[2][2][4][2], const Unit& u, int wr, int wc, int fr, int fq) const {
        const int row0 = u.pm * BM + wr * 64 + fr, hid0 = u.pn * HALF + wc * 32 + 8 * fq;
#pragma unroll
        for (int ai = 0; ai < 2; ++ai)
#pragma unroll
            for (int m = 0; m < 4; ++m) { bf16_t* rowp = H + (size_t)(row0 + ai * HALF + m * 16) * 2816 + hid0;
                f32x4 g0 = acc[ai][0][m][0], g1 = acc[ai][0][m][1]; const f32x4 u0 = acc[ai][1][m][0], u1 = acc[ai][1][m][1];
#pragma unroll
                for (int j = 0; j < 4; ++j) { g0[j] = silu_f(g0[j]) * u0[j]; g1[j] = silu_f(g1[j]) * u1[j]; }
                u32x4 w; w.x = cvt_pk_bf16(g0[0], g0[1]); w.y = cvt_pk_bf16(g0[2], g0[3]); w.z = cvt_pk_bf16(g1[0], g1[1]); w.w = cvt_pk_bf16(g1[2], g1[3]);
                *(u32x4*)rowp = w; }
    }
};

struct EpiAll {
    static constexpr bool AFTER_DRAIN = false;
    int mode; bool perm, align; EpiIn ein; EpiRes eres; EpiGU egu;
    __device__ __forceinline__ void operator()(const f32x4 (&acc)[2][2][4][2], const Unit& u, int wr, int wc, int fr, int fq) const {
        if (mode == 0) ein(acc, u, wr, wc, fr, fq); else if (mode == 1) eres(acc, u, wr, wc, fr, fq); else egu(acc, u, wr, wc, fr, fq);
    }
};

template <class Epi, class Sched, bool ALIGN_EPI = false, bool SP2 = false>
__device__ __forceinline__ void gemm_phase(PG8_LAS unsigned char* lds, const Gemm g, const Sched& S, const Epi& E) {
    int tid_o = threadIdx.x; asm volatile("" : "+v"(tid_o));
    const int tid = tid_o, wid = __builtin_amdgcn_readfirstlane(tid >> 6), lane = tid & 63, wr = wid >> 2, wc = wid & 3, fr = lane & 15, fq = lane >> 4;
    const int K = g.K, nt = K / BK;
    unsigned voffA[2], voffB[2];
#pragma unroll
    for (int i = 0; i < 2; ++i) { int R, C; stage_rc(tid * 16 + i * 8192, R, C); const int Rb = E.perm ? ((R & ~31) + perm32(R & 31)) : R;
        voffA[i] = (unsigned)(R * K + C) * 2u; voffB[i] = (unsigned)(Rb * K + C) * 2u; }
    const size_t kstep = (size_t)(BK * 2);
    const size_t hstep = (size_t)HALF * K * 2;
    const size_t tstep = 2 * hstep;
    const unsigned ldsw = (unsigned)wid * 1024u;
    const int aoff = lds_byte(wr * 64 + fr, fq * 8), boff = lds_byte(wc * 32 + fr, fq * 8);
#define PG8_SA(b, h) (((b) * 2 + (h)) * HTB)
#define PG8_SB(b, h) ((4 + (b) * 2 + (h)) * HTB)
#define PG8_STAGE(bufoff, gbase, voff) do { _Pragma("unroll") for (int _i = 0; _i < 2; ++_i) \
        __builtin_amdgcn_global_load_lds((const unsigned*)((const char*)(gbase) + (voff)[_i]), (PG8_LAS unsigned*)(lds + (bufoff) + ldsw + _i * 8192), 16, 0, 0); } while (0)
#define PG8_LDA(dst, b, h) do { _Pragma("unroll") for (int m = 0; m < 4; ++m) _Pragma("unroll") for (int k = 0; k < 2; ++k) dst[m][k] = *(const PG8_LAS bf16x8*)(lds + PG8_SA(b, h) + aoff + m * 2048 + k * 1024); } while (0)
#define PG8_LDB(dst, b, h) do { _Pragma("unroll") for (int n = 0; n < 2; ++n) _Pragma("unroll") for (int k = 0; k < 2; ++k) dst[n][k] = *(const PG8_LAS bf16x8*)(lds + PG8_SB(b, h) + boff + n * 2048 + k * 1024); } while (0)
#define PG8_MMA(ai, bj, At, Bt) do { __builtin_amdgcn_s_setprio(1); _Pragma("unroll") for (int m = 0; m < 4; ++m) _Pragma("unroll") for (int n = 0; n < 2; ++n) _Pragma("unroll") for (int k = 0; k < 2; ++k) \
        acc[ai][bj][m][n] = __builtin_amdgcn_mfma_f32_16x16x32_bf16(Bt[n][k], At[m][k], acc[ai][bj][m][n], 0, 0, 0); __builtin_amdgcn_s_setprio(0); } while (0)
#define PG8_WAIT_V(n) asm volatile("s_waitcnt vmcnt(" #n ")" ::: "memory")
#define PG8_WAIT_L(n) asm volatile("s_waitcnt lgkmcnt(" #n ")" ::: "memory")
#define PG8_BAR __builtin_amdgcn_s_barrier()
#define PG8_SCHED __builtin_amdgcn_sched_barrier(0)
    Unit cur, nxt; int ui = 0;
    if (!S.next(0, cur)) return;
    f32x4 acc[2][2][4][2];
#pragma unroll
    for (int a = 0; a < 2; ++a)
#pragma unroll
        for (int b = 0; b < 2; ++b)
#pragma unroll
            for (int m = 0; m < 4; ++m)
#pragma unroll
                for (int n = 0; n < 2; ++n) acc[a][b][m][n] = (f32x4){0.f, 0.f, 0.f, 0.f};
    bf16x8 At[4][2], B0[2][2], B1[2][2];
    const char* cA = (const char*)g.A + (size_t)cur.pm * tstep; const char* cB = (const char*)g.Bt + (size_t)cur.pn * tstep;
    S.a_ready(cur);
    if constexpr (SP2) {
        PG8_STAGE(PG8_SB(0, 0), cB, voffB); PG8_STAGE(PG8_SB(0, 1), cB + hstep, voffB); PG8_STAGE(PG8_SA(0, 0), cA, voffA); PG8_STAGE(PG8_SA(0, 1), cA + hstep, voffA);
        if (wr == 1) PG8_BAR;
        PG8_WAIT_V(2); PG8_BAR;
        PG8_STAGE(PG8_SB(1, 0), cB + kstep, voffB); PG8_STAGE(PG8_SA(1, 0), cA + kstep, voffA); PG8_STAGE(PG8_SB(1, 1), cB + hstep + kstep, voffB);
        PG8_WAIT_V(6); PG8_BAR;
    } else {
        PG8_STAGE(PG8_SB(0, 0), cB, voffB); PG8_STAGE(PG8_SA(0, 0), cA, voffA); PG8_STAGE(PG8_SB(0, 1), cB + hstep, voffB); PG8_STAGE(PG8_SA(0, 1), cA + hstep, voffA);
        if (wr == 1) PG8_BAR;
        PG8_WAIT_V(4); PG8_BAR;
        PG8_STAGE(PG8_SB(1, 0), cB + kstep, voffB); PG8_STAGE(PG8_SA(1, 0), cA + kstep, voffA); PG8_STAGE(PG8_SB(1, 1), cB + hstep + kstep, voffB);
        PG8_WAIT_V(6); PG8_BAR;
    }
    for (;;) {
        const bool has_next = S.next(ui + 1, nxt);
        const char* nA = has_next ? (const char*)g.A + (size_t)nxt.pm * tstep : cA; const char* nB = has_next ? (const char*)g.Bt + (size_t)nxt.pn * tstep : cB;
        for (int t = 0; t < nt; t += 2) {
            const bool last = (t == nt - 2);
            const char* a1 = cA + (size_t)(t + 1) * kstep;
            const char* a2 = last ? nA : cA + (size_t)(t + 2) * kstep; const char* b2 = last ? nB : cB + (size_t)(t + 2) * kstep;
            const char* a3 = a2 + kstep; const char* b3 = b2 + kstep;
            if (last && has_next) S.a_ready(nxt);
            if constexpr (SP2) {
            PG8_LDB(B0, 0, 0); PG8_LDB(B1, 0, 1); PG8_SCHED; PG8_LDA(At, 0, 0); PG8_STAGE(PG8_SA(1, 1), a1 + hstep, voffA);
            PG8_WAIT_V(8); PG8_WAIT_L(0); PG8_BAR; PG8_MMA(0, 0, At, B0); PG8_MMA(0, 1, At, B1); PG8_BAR; PG8_SCHED;
            PG8_LDA(At, 0, 1); PG8_STAGE(PG8_SB(0, 0), b2, voffB); PG8_STAGE(PG8_SB(0, 1), b2 + hstep, voffB); PG8_STAGE(PG8_SA(0, 0), a2, voffA);
            PG8_WAIT_V(8); PG8_WAIT_L(0); PG8_BAR; PG8_MMA(1, 0, At, B0); PG8_MMA(1, 1, At, B1); PG8_BAR; PG8_SCHED;
            PG8_LDB(B0, 1, 0); PG8_LDB(B1, 1, 1); PG8_SCHED; PG8_LDA(At, 1, 0); PG8_STAGE(PG8_SA(0, 1), a2 + hstep, voffA);
            PG8_WAIT_V(8); PG8_WAIT_L(0); PG8_BAR; PG8_MMA(0, 0, At, B0); PG8_MMA(0, 1, At, B1); PG8_BAR; PG8_SCHED;
            PG8_LDA(At, 1, 1); PG8_STAGE(PG8_SB(1, 0), b3, voffB); PG8_STAGE(PG8_SB(1, 1), b3 + hstep, voffB); PG8_STAGE(PG8_SA(1, 0), a3, voffA);
            PG8_WAIT_V(8); PG8_WAIT_L(0); PG8_BAR; PG8_MMA(1, 0, At, B0); PG8_MMA(1, 1, At, B1); PG8_BAR; PG8_SCHED;
            } else {
            PG8_LDB(B0, 0, 0); PG8_SCHED; PG8_LDA(At, 0, 0); PG8_STAGE(PG8_SA(1, 1), a1 + hstep, voffA);
            PG8_WAIT_L(8); PG8_BAR; PG8_WAIT_L(0); PG8_MMA(0, 0, At, B0); PG8_BAR; PG8_SCHED;
            PG8_LDB(B1, 0, 1); PG8_STAGE(PG8_SB(0, 0), b2, voffB);
            PG8_BAR; PG8_WAIT_L(0); PG8_MMA(0, 1, At, B1); PG8_BAR;
            PG8_LDA(At, 0, 1); PG8_STAGE(PG8_SA(0, 0), a2, voffA);
            PG8_BAR; PG8_WAIT_L(0); PG8_MMA(1, 0, At, B0); PG8_BAR; PG8_SCHED;
            PG8_STAGE(PG8_SB(0, 1), b2 + hstep, voffB);
            PG8_WAIT_V(6); PG8_BAR; PG8_MMA(1, 1, At, B1); PG8_BAR;
            PG8_LDB(B0, 1, 0); PG8_SCHED; PG8_LDA(At, 1, 0); PG8_STAGE(PG8_SA(0, 1), a2 + hstep, voffA);
            PG8_WAIT_L(8); PG8_BAR; PG8_WAIT_L(0); PG8_MMA(0, 0, At, B0); PG8_BAR; PG8_SCHED;
            PG8_LDB(B1, 1, 1); PG8_STAGE(PG8_SB(1, 0), b3, voffB);
            PG8_BAR; PG8_WAIT_L(0); PG8_MMA(0, 1, At, B1); PG8_BAR;
            PG8_LDA(At, 1, 1); PG8_STAGE(PG8_SA(1, 0), a3, voffA);
            PG8_BAR; PG8_WAIT_L(0); PG8_MMA(1, 0, At, B0); PG8_BAR; PG8_SCHED;
            PG8_STAGE(PG8_SB(1, 1), b3 + hstep, voffB);
            PG8_WAIT_V(6); PG8_BAR; PG8_MMA(1, 1, At, B1); PG8_BAR;
            }
        }
        if (E.align) { if (wr == 0) PG8_BAR; }
        if constexpr (!Epi::AFTER_DRAIN) { E(acc, cur, wr, wc, fr, fq); S.done(cur); }
        if (!has_next) break;
#pragma unroll
        for (int a = 0; a < 2; ++a)
#pragma unroll
            for (int b = 0; b < 2; ++b)
#pragma unroll
                for (int m = 0; m < 4; ++m)
#pragma unroll
                    for (int n = 0; n < 2; ++n) acc[a][b][m][n] = (f32x4){0.f, 0.f, 0.f, 0.f};
        cur = nxt; cA = nA; cB = nB; ++ui;
        if (E.align) { if (wr == 1) PG8_BAR; }
    }
    PG8_WAIT_V(0);
    if (!E.align) { if (wr == 0) PG8_BAR; }
    PG8_BAR;
    if constexpr (Epi::AFTER_DRAIN) { E.fused(acc, cur, wr, wc, fr, fq, lds, wid, lane); S.done(cur); }
#undef PG8_SA
#undef PG8_SB
#undef PG8_STAGE
#undef PG8_LDA
#undef PG8_LDB
#undef PG8_MMA
#undef PG8_WAIT_V
#undef PG8_WAIT_L
#undef PG8_BAR
#undef PG8_SCHED
}
}

#define LAS __attribute__((address_space(3)))
typedef unsigned short bf16;
typedef float f32x4 __attribute__((ext_vector_type(4)));
typedef unsigned u32x4v __attribute__((ext_vector_type(4)));
typedef unsigned u32x2v __attribute__((ext_vector_type(2)));
constexpr int NWAVES = 8, NT = 512;
constexpr int DM = 1024, SEQ = 16384, R_LAT = 32768, R_CTX = 512, R_ALL = 33280, INW = 2304, FF = 2816, GUW = 5632, DEPTH = 4;
constexpr int C_RQ = 0, C_RK = 256, C_RV = 512, C_RG = 768, C_AQ = 1024, C_AK = 1536, C_AV = 1664, C_CU = 1792, C_CV = 2048;
constexpr int NCHUNK = 260;
constexpr float LOG2E = 1.4426950408889634f;
constexpr float EPS = 1e-6f;
constexpr size_t MiB = 1u << 20;
constexpr size_t WS_BAR = 0, BAR_ZERO_BYTES = 16384;
constexpr size_t WS_MOD = 1 * MiB;
constexpr size_t WS_ROPE = WS_MOD + 512 * 1024;
constexpr size_t WS_DEC = WS_MOD + 768 * 1024;
constexpr size_t WS_W0 = 2 * MiB, WBUF_BYTES = 24 * MiB;
constexpr size_t WO_IN = 0, WO_OUT = (size_t)INW * DM * 2, WO_GU = WO_OUT + (size_t)DM * DM * 2, WO_DN = WO_GU + (size_t)GUW * DM * 2, WO_WS = WO_DN + (size_t)DM * FF * 2, WO_END = WO_WS + 4 * 128 * 128 * 2;
static_assert(WO_END <= WBUF_BYTES, "weight buffer");
constexpr size_t WS_X = WS_W0 + 2 * WBUF_BYTES;
constexpr size_t WS_ZM = WS_X + 130 * MiB;
constexpr size_t WS_PH = WS_ZM + 65 * MiB;
constexpr size_t WS_D = WS_PH + 179 * MiB;
constexpr size_t WS_S = WS_D + 33 * MiB;
constexpr size_t WS_END = WS_S + 17 * MiB;
static_assert((size_t)R_ALL * DM * 4 <= 130 * MiB && (size_t)R_ALL * DM * 2 <= 65 * MiB && (size_t)R_ALL * FF * 2 <= 179 * MiB && (size_t)NCHUNK * 8 * 4096 * 4 <= 33 * MiB, "ws map");
constexpr int LDS_BYTES = 147456;

struct Args {
    const float *x, *c, *ctx, *c_ctx, *w_mod, *b_mod, *norm1_g, *norm2_g, *w_in, *ret_decay_f, *ret_decay_b, *ret_norm_g, *attn_sink, *cm_norm_g, *cm_w_s, *cm_b_s, *w_out, *w_gate, *w_up, *w_down, *final_norm_g;
    float* out; unsigned char* ws; int ph_lo, ph_hi, rep_mask, sync_rep;
};

typedef const __attribute__((address_space(4))) Args* KArgs;

__device__ __forceinline__ float bf_lo(unsigned w) { return __uint_as_float(w << 16); }
__device__ __forceinline__ float bf_hi(unsigned w) { return __uint_as_float(w & 0xffff0000u); }
__device__ __forceinline__ unsigned f2bf(float f) { unsigned u = __float_as_uint(f); return (u + 0x7fffu + ((u >> 16) & 1u)) >> 16; }
__device__ __forceinline__ unsigned pk2(float lo, float hi) { return pg8::cvt_pk_bf16(lo, hi); }
__device__ __forceinline__ float wave_sum(float v) {
#pragma unroll
    for (int o = 1; o < 64; o <<= 1) v += __shfl_xor(v, o);
    return v;
}
__device__ __forceinline__ float log_sigmoid_f(float x) { return -log1pf(expf(-x)); }
#define UNPACK8(dst, off, PW) do { dst[(off) + 0] = bf_lo((PW)[0]); dst[(off) + 1] = bf_hi((PW)[0]); dst[(off) + 2] = bf_lo((PW)[1]); dst[(off) + 3] = bf_hi((PW)[1]); \
    dst[(off) + 4] = bf_lo((PW)[2]); dst[(off) + 5] = bf_hi((PW)[2]); dst[(off) + 6] = bf_lo((PW)[3]); dst[(off) + 7] = bf_hi((PW)[3]); } while (0)

template <int MAP> __device__ __forceinline__ int map_col(int n) {
    if (MAP == 1) { const bool qk = (n < 512) || (n >= 1024 && n < 1664); if (!qk) return n; const int d = n & 63, hf = d >> 5, w = d & 31, j = w & 15, sec = w >> 4; return (n & ~63) + hf * 32 + 2 * j + sec; }
    if (MAP == 2) return 256 * (n >> 7) + (n & 127);
    if (MAP == 3) return 256 * (n >> 7) + 128 + (n & 127);
    return n;
}
template <int MAP> __device__ __forceinline__ void transpose_item(const float* W, int K, int N, bf16* WT, LAS float* scr, int item, int lane) {
    const int nblk = N / 32, kb = item / nblk, nb = item % nblk, k0 = 64 * kb, n0 = 32 * nb;
#pragma unroll
    for (int i = 0; i < 32; ++i) { const int kk = 2 * i + (lane >> 5); scr[kk * 33 + (lane & 31)] = W[(size_t)(k0 + kk) * N + n0 + (lane & 31)]; }
    asm volatile("s_waitcnt lgkmcnt(0)" ::: "memory");
    const int c = lane & 7;
#pragma unroll
    for (int j = 0; j < 4; ++j) { const int n = (lane >> 3) + 8 * j; const LAS float* s = scr + (8 * c) * 33 + n;
        u32x4v o; o.x = pk2(s[0 * 33], s[1 * 33]); o.y = pk2(s[2 * 33], s[3 * 33]); o.z = pk2(s[4 * 33], s[5 * 33]); o.w = pk2(s[6 * 33], s[7 * 33]);
        *(u32x4v*)(WT + (size_t)map_col<MAP>(n0 + n) * K + k0 + 8 * c) = o; }
    asm volatile("s_waitcnt lgkmcnt(0)" ::: "memory");
}
__device__ __forceinline__ void convert_weights(KArgs a, int l, unsigned char* wb, LAS unsigned char* lds, int gw, int ngw, int wave, int lane) {
    LAS float* scr = (LAS float*)(lds + wave * 16384);
    constexpr int I_IN = 16 * 72, I_OUT = 16 * 32, I_G = 16 * 88, I_D = 44 * 32, I_WS = 16;
    constexpr int NIT = I_IN + I_OUT + 2 * I_G + I_D + I_WS;
    for (int it = gw; it < NIT; it += ngw) {
        int r = it;
        if (r < I_IN) { transpose_item<1>(a->w_in + (size_t)l * DM * INW, DM, INW, (bf16*)(wb + WO_IN), scr, r, lane); continue; } r -= I_IN;
        if (r < I_OUT) { transpose_item<0>(a->w_out + (size_t)l * DM * DM, DM, DM, (bf16*)(wb + WO_OUT), scr, r, lane); continue; } r -= I_OUT;
        if (r < I_G) { transpose_item<2>(a->w_gate + (size_t)l * DM * FF, DM, FF, (bf16*)(wb + WO_GU), scr, r, lane); continue; } r -= I_G;
        if (r < I_G) { transpose_item<3>(a->w_up + (size_t)l * DM * FF, DM, FF, (bf16*)(wb + WO_GU), scr, r, lane); continue; } r -= I_G;
        if (r < I_D) { transpose_item<0>(a->w_down + (size_t)l * FF * DM, FF, DM, (bf16*)(wb + WO_DN), scr, r, lane); continue; } r -= I_D;
        { const float* src = a->cm_w_s + (size_t)l * 65536 + r * 4096; bf16* dst = (bf16*)(wb + WO_WS) + r * 4096;
            for (int i = lane; i < 1024; i += 64) { const f32x4 v = *(const f32x4*)(src + 4 * i); u32x2v o; o.x = pk2(v[0], v[1]); o.y = pk2(v[2], v[3]); *(u32x2v*)(dst + 4 * i) = o; } }
    }
}
__device__ __forceinline__ void mod_phase(KArgs a, float* MOD, LAS unsigned char* lds, int bid, int G, int tid) {
    LAS float* sc = (LAS float*)lds;
    LAS float* red = (LAS float*)(lds + 16384);
    for (int i = tid; i < 3072; i += NT) { const float v = i < 2048 ? a->c[i] : a->c_ctx[i - 2048]; sc[i] = v / (1.0f + __expf(-v)); }
    __syncthreads();
    const int cx = tid & 31, ks = tid >> 5;
    for (int it = bid; it < 4 * 48; it += G) {
        const int l = it / 48, cb = it % 48;
        const float* W = a->w_mod + (size_t)l * DM * 6144 + cb * 128 + cx * 4;
        f32x4 a0 = {0.f, 0.f, 0.f, 0.f}, a1 = a0, a2 = a0;
#pragma unroll 32
        for (int k = ks * 64; k < ks * 64 + 64; ++k) { const f32x4 w = *(const f32x4*)(W + (size_t)k * 6144); a0 += w * sc[k]; a1 += w * sc[1024 + k]; a2 += w * sc[2048 + k]; }
        *(LAS f32x4*)(red + (ks * 3 + 0) * 128 + cx * 4) = a0; *(LAS f32x4*)(red + (ks * 3 + 1) * 128 + cx * 4) = a1; *(LAS f32x4*)(red + (ks * 3 + 2) * 128 + cx * 4) = a2;
        __syncthreads();
        if (tid < 384) { const int s = tid >> 7, col = tid & 127; float v = a->b_mod[l * 6144 + cb * 128 + col];
#pragma unroll
            for (int k = 0; k < 16; ++k) v += red[(k * 3 + s) * 128 + col];
            MOD[(size_t)(l * 3 + s) * 6144 + cb * 128 + col] = v; }
        __syncthreads();
    }
}
template <int MODE> __device__ __forceinline__ void norm_phase(KArgs a, float* XRES, bf16* ZN, const float* gvec, const float* mod_shift  , int nrows, int gw, int ngw, int lane) {
    f32x4 gm[4], hs[4]; int scur = -1;
#define NIDX(j) (2 * lane + 128 * ((j) >> 1) + ((j) & 1))
    if (MODE == 2) {
#pragma unroll
        for (int j = 0; j < 4; ++j) gm[j] = *((const f32x4*)gvec + NIDX(j)); }
    for (int row = gw; row < nrows; row += ngw) {
        const float* src = (MODE == 1) ? (row < R_LAT ? a->x + (size_t)row * DM : a->ctx + (size_t)(row - R_LAT) * DM) : XRES + (size_t)row * DM;
        const f32x4* xr = (const f32x4*)src;
        f32x4 v[4]; float ss = 0.f;
#pragma unroll
        for (int j = 0; j < 4; ++j) { v[j] = xr[NIDX(j)]; ss += (v[j][0] * v[j][0] + v[j][1] * v[j][1]) + (v[j][2] * v[j][2] + v[j][3] * v[j][3]); }
        if (MODE != 2) { const int s = row < SEQ ? 0 : (row < R_LAT ? 1 : 2);
            if (s != scur) { scur = s; const float* sh = mod_shift + s * 6144; const float* scl = sh + 1024;
#pragma unroll
                for (int j = 0; j < 4; ++j) { gm[j] = *((const f32x4*)gvec + NIDX(j)) * (*((const f32x4*)scl + NIDX(j)) + 1.0f); hs[j] = *((const f32x4*)sh + NIDX(j)); } } }
        const float rstd = __builtin_amdgcn_rsqf(wave_sum(ss) * (1.0f / DM) + EPS);
        if (MODE == 2) { f32x4* o = (f32x4*)(a->out + (size_t)row * DM);
#pragma unroll
            for (int j = 0; j < 4; ++j) o[NIDX(j)] = v[j] * rstd * gm[j]; }
        else { u32x4v* o = (u32x4v*)(ZN + (size_t)row * DM);
#pragma unroll
            for (int h = 0; h < 2; ++h) { const f32x4 z0 = v[2 * h] * rstd * gm[2 * h] + hs[2 * h], z1 = v[2 * h + 1] * rstd * gm[2 * h + 1] + hs[2 * h + 1];
                u32x4v w; w[0] = pk2(z0[0], z0[1]); w[1] = pk2(z0[2], z0[3]); w[2] = pk2(z1[0], z1[1]); w[3] = pk2(z1[2], z1[3]); o[lane + 64 * h] = w; } }
    }
#undef NIDX
}

__device__ __forceinline__ void attn_naive_item(int item, const bf16* P, bf16* MIX, const float* sink, int tid) {
    const int rb = item >> 1, hk = item & 1, g = tid >> 7, r = tid & 127, hq = hk * 4 + g, row = rb * 128 + r;
    float q[64], o[64];
    { const u32x4v* qp = (const u32x4v*)(P + (size_t)row * INW + C_AQ + hq * 64);
#pragma unroll
      for (int i = 0; i < 8; ++i) { const u32x4v w = qp[i]; UNPACK8(q, 8 * i, w); } }
#pragma unroll
    for (int d = 0; d < 64; ++d) o[d] = 0.f;
    float m = -1e30f, lsum = 0.f;
    for (int sg = 0; sg < 4; ++sg) {
        int krow0, nk, mode;
        if (rb < 256) { const int b = rb >> 7, i = rb & 127;
            if (sg == 0) { if (i == 0) continue; krow0 = (rb - 1) * 128; nk = 128; mode = 1; }
            else if (sg == 1) { krow0 = rb * 128; nk = 128; mode = 0; }
            else if (sg == 2) { if (i == 127) continue; krow0 = (rb + 1) * 128; nk = 128; mode = 2; }
            else { krow0 = R_LAT + b * 256; nk = 256; mode = 0; } }
        else { if (sg != 3) continue; const int b = (rb - 256) >> 1; krow0 = R_LAT + b * 256; nk = 256; mode = 0; }
        for (int c = 0; c < nk; ++c) {
            const u32x4v* kp = (const u32x4v*)(P + (size_t)(krow0 + c) * INW + C_AK + hk * 64);
            float s = 0.f;
#pragma unroll
            for (int i = 0; i < 8; ++i) { const u32x4v w = kp[i]; float kk[8]; UNPACK8(kk, 0, w);
#pragma unroll
                for (int e = 0; e < 8; ++e) s += q[8 * i + e] * kk[e]; }
            const bool valid = (mode == 0) || (mode == 1 ? (c >= r) : (c <= r));
            s = valid ? s : -INFINITY;
            const float mn = fmaxf(m, s), al = exp2f(m - mn), p = exp2f(s - mn);
            lsum = lsum * al + p; m = mn;
            const u32x4v* vp = (const u32x4v*)(P + (size_t)(krow0 + c) * INW + C_AV + hk * 64);
#pragma unroll
            for (int i = 0; i < 8; ++i) { const u32x4v w = vp[i]; float vv[8]; UNPACK8(vv, 0, w);
#pragma unroll
                for (int e = 0; e < 8; ++e) o[8 * i + e] = o[8 * i + e] * al + p * vv[e]; }
        }
    }
    { const float sl = sink[hq] * LOG2E, mf = fmaxf(m, sl), al = exp2f(m - mf); lsum = lsum * al + exp2f(sl - mf); const float inv = al / lsum;
      u32x4v* op = (u32x4v*)(MIX + (size_t)row * DM + 256 + hq * 64);
#pragma unroll
      for (int i = 0; i < 8; ++i) { u32x4v w; w.x = pk2(o[8 * i] * inv, o[8 * i + 1] * inv); w.y = pk2(o[8 * i + 2] * inv, o[8 * i + 3] * inv); w.z = pk2(o[8 * i + 4] * inv, o[8 * i + 5] * inv); w.w = pk2(o[8 * i + 6] * inv, o[8 * i + 7] * inv); op[i] = w; } }
}
__device__ __forceinline__ void gmlp_naive_item(int ch, const bf16* P, bf16* MIX, const float* norm_g, const float* w_s, const float* b_s, LAS unsigned char* lds, int tid) {
    LAS float* vn = (LAS float*)lds;
    const int g = tid >> 7, p = tid & 127, row = ch * 128 + p;
    { float v[64]; const u32x4v* vp = (const u32x4v*)(P + (size_t)row * INW + C_CV + g * 64);
#pragma unroll
      for (int i = 0; i < 8; ++i) { const u32x4v w = vp[i]; UNPACK8(v, 8 * i, w); }
      float s = 0.f;
#pragma unroll
      for (int d = 0; d < 64; ++d) s += v[d];
      const float mu = s * (1.0f / 64.0f); float qq = 0.f;
#pragma unroll
      for (int d = 0; d < 64; ++d) { v[d] -= mu; qq += v[d] * v[d]; }
      const float rstd = 1.0f / sqrtf(qq * (1.0f / 64.0f) + EPS);
#pragma unroll
      for (int d = 0; d < 64; ++d) vn[p * 256 + g * 64 + d] = v[d] * rstd * norm_g[g * 64 + d]; }
    __syncthreads();
    float acc[64];
#pragma unroll
    for (int d = 0; d < 64; ++d) acc[d] = 0.f;
    const float* wrow = w_s + (size_t)(g * 128 + p) * 128;
    for (int qi = 0; qi < 128; ++qi) { const float w = wrow[qi]; const LAS f32x4* vr = (const LAS f32x4*)(vn + qi * 256 + g * 64);
#pragma unroll
        for (int i = 0; i < 16; ++i) { const f32x4 x = vr[i]; acc[4 * i] += w * x[0]; acc[4 * i + 1] += w * x[1]; acc[4 * i + 2] += w * x[2]; acc[4 * i + 3] += w * x[3]; } }
    const float bs = b_s[g * 128 + p];
    const u32x4v* up = (const u32x4v*)(P + (size_t)row * INW + C_CU + g * 64); u32x4v* op = (u32x4v*)(MIX + (size_t)row * DM + 768 + g * 64);
#pragma unroll
    for (int i = 0; i < 8; ++i) { const u32x4v w = up[i]; float uu[8]; UNPACK8(uu, 0, w);
#pragma unroll
        for (int e = 0; e < 8; ++e) uu[e] *= (acc[8 * i + e] + bs);
        u32x4v o; o.x = pk2(uu[0], uu[1]); o.y = pk2(uu[2], uu[3]); o.z = pk2(uu[4], uu[5]); o.w = pk2(uu[6], uu[7]); op[i] = o; }
    __syncthreads();
}
__device__ __forceinline__ void retd_naive_item(int item, const bf16* P, float* DB, float l2f, float l2b, LAS unsigned char* lds, int tid) {
    const int ch = item >> 2, h = item & 3;
    LAS float* Ks = (LAS float*)lds; LAS float* Vs = Ks + 8192; LAS float* wf = Vs + 8192; LAS float* wb = wf + 128;
    for (int i = tid; i < 1024; i += NT) { const int j = i >> 3, c8 = (i & 7) * 8; const size_t ro = (size_t)(ch * 128 + j) * INW + h * 64 + c8;
        const u32x4v kw = *(const u32x4v*)(P + ro + C_RK), vw = *(const u32x4v*)(P + ro + C_RV); float t[8];
        UNPACK8(t, 0, kw);
#pragma unroll
        for (int e = 0; e < 8; ++e) Ks[j * 64 + c8 + e] = t[e];
        UNPACK8(t, 0, vw);
#pragma unroll
        for (int e = 0; e < 8; ++e) Vs[j * 64 + c8 + e] = t[e]; }
    if (tid < 128) { wf[tid] = exp2f((float)(127 - tid) * l2f); wb[tid] = exp2f((float)tid * l2b); }
    __syncthreads();
    float* Df = DB + (size_t)(item * 2) * 4096; float* Dbk = Df + 4096;
#pragma unroll 1
    for (int i = 0; i < 8; ++i) { const int e = tid + NT * i, dv = e >> 6, dk = e & 63; float af = 0.f, ab = 0.f;
        for (int j = 0; j < 128; ++j) { const float kv = Ks[j * 64 + dk] * Vs[j * 64 + dv]; af += wf[j] * kv; ab += wb[j] * kv; }
        Df[e] = af; Dbk[e] = ab; }
    __syncthreads();
}
__device__ __forceinline__ void scan_phase(const float* __restrict__ DB, bf16* __restrict__ SB, const float* decay_f, const float* decay_b, int gtid, int gthreads) {
    for (int id = gtid; id < 65536; id += gthreads) {
        const int e = id & 4095, dir = (id >> 12) & 1, h = (id >> 13) & 3, b = id >> 15;
        const float cd = exp2f(128.0f * (dir ? decay_b[h] : decay_f[h]));
        const size_t off = (size_t)(h * 2 + dir) * 4096 + e;
        const int c0 = 256 + 2 * b, c1 = c0 + 1;
        const int first = dir ? c1 : c0, second = dir ? c0 : c1;
        const float d0 = DB[(size_t)first * 32768 + off], d1 = DB[(size_t)second * 32768 + off];
        float s = d0;
        SB[(size_t)first * 32768 + off] = (bf16)0;
        SB[(size_t)second * 32768 + off] = (bf16)f2bf(s); s = s * cd + d1;
#pragma unroll 1
        for (int i0 = 0; i0 < 128; i0 += 32) {
            float d[32];
#pragma unroll
            for (int i = 0; i < 32; ++i) { const int ch = b * 128 + (dir ? 127 - (i0 + i) : (i0 + i)); d[i] = DB[(size_t)ch * 32768 + off]; }
#pragma unroll
            for (int i = 0; i < 32; ++i) { const int ch = b * 128 + (dir ? 127 - (i0 + i) : (i0 + i)); SB[(size_t)ch * 32768 + off] = (bf16)f2bf(s); s = s * cd + d[i]; }
        }
    }
}
__device__ __forceinline__ void reto_naive_item(int item, const bf16* P, const bf16* SB, bf16* MIX, const float* norm_g, float l2f, float l2b, int tid) {
    const int ch = item >> 2, h = item & 3, r = tid >> 2, qt = tid & 3, row = ch * 128 + r;
    float q[64], o[16];
    { const u32x4v* qp = (const u32x4v*)(P + (size_t)row * INW + C_RQ + h * 64);
#pragma unroll
      for (int i = 0; i < 8; ++i) { const u32x4v w = qp[i]; UNPACK8(q, 8 * i, w); } }
#pragma unroll
    for (int d = 0; d < 16; ++d) o[d] = 0.f;
    for (int j = 0; j < 128; ++j) {
        const u32x4v* kp = (const u32x4v*)(P + (size_t)(ch * 128 + j) * INW + C_RK + h * 64);
        float s = 0.f;
#pragma unroll
        for (int i = 0; i < 8; ++i) { const u32x4v w = kp[i]; float kk[8]; UNPACK8(kk, 0, w);
#pragma unroll
            for (int e = 0; e < 8; ++e) s += q[8 * i + e] * kk[e]; }
        const float w = (r > j) ? exp2f((float)(r - j) * l2f) : ((r < j) ? exp2f((float)(j - r) * l2b) : 2.0f);
        s *= w;
        const u32x4v* vp = (const u32x4v*)(P + (size_t)(ch * 128 + j) * INW + C_RV + h * 64 + qt * 16);
#pragma unroll
        for (int i = 0; i < 2; ++i) { const u32x4v vw = vp[i]; float vv[8]; UNPACK8(vv, 0, vw);
#pragma unroll
            for (int e = 0; e < 8; ++e) o[8 * i + e] += s * vv[e]; }
    }
    { const float qdf = exp2f((float)(r + 1) * l2f), qdb = exp2f((float)(128 - r) * l2b);
      const bf16* Sf = SB + (size_t)(item * 2) * 4096; const bf16* Sb = Sf + 4096;
#pragma unroll 1
      for (int d = 0; d < 16; ++d) { const int dv = qt * 16 + d; const u32x4v* fp = (const u32x4v*)(Sf + dv * 64); const u32x4v* bp = (const u32x4v*)(Sb + dv * 64); float tf = 0.f, tb = 0.f;
#pragma unroll
          for (int i = 0; i < 8; ++i) { const u32x4v wf = fp[i], wb = bp[i]; float ff[8], bb[8]; UNPACK8(ff, 0, wf); UNPACK8(bb, 0, wb);
#pragma unroll
              for (int e = 0; e < 8; ++e) { tf += q[8 * i + e] * ff[e]; tb += q[8 * i + e] * bb[e]; } }
          const float t = qdf * tf + qdb * tb;
#pragma unroll
          for (int dd = 0; dd < 16; ++dd) o[dd] += (dd == d) ? t : 0.f; } }
    float s = 0.f;
#pragma unroll
    for (int d = 0; d < 16; ++d) s += o[d];
    s += __shfl_xor(s, 1); s += __shfl_xor(s, 2);
    const float mu = s * (1.0f / 64.0f); float qq = 0.f;
#pragma unroll
    for (int d = 0; d < 16; ++d) { o[d] -= mu; qq += o[d] * o[d]; }
    qq += __shfl_xor(qq, 1); qq += __shfl_xor(qq, 2);
    const float rstd = 1.0f / sqrtf(qq * (1.0f / 64.0f) + EPS);
    const u32x4v* gp = (const u32x4v*)(P + (size_t)row * INW + C_RG + h * 64 + qt * 16); u32x4v* op = (u32x4v*)(MIX + (size_t)row * DM + h * 64 + qt * 16);
#pragma unroll
    for (int i = 0; i < 2; ++i) { const u32x4v gw = gp[i]; float gg[8]; UNPACK8(gg, 0, gw);
#pragma unroll
        for (int e = 0; e < 8; ++e) gg[e] *= o[8 * i + e] * rstd * norm_g[h * 64 + qt * 16 + 8 * i + e];
        u32x4v w; w.x = pk2(gg[0], gg[1]); w.y = pk2(gg[2], gg[3]); w.z = pk2(gg[4], gg[5]); w.w = pk2(gg[6], gg[7]); op[i] = w; }
}

typedef short bf16x8 __attribute__((ext_vector_type(8)));
typedef short s16x4 __attribute__((ext_vector_type(4)));
__device__ __forceinline__ s16x4 tr16(LAS const unsigned char* p) { return __builtin_bit_cast(s16x4, __builtin_amdgcn_ds_read_tr16_b64_v4i16((LAS s16x4*)p)); }
__device__ __forceinline__ bf16x8 cat8(s16x4 a, s16x4 b) { return (bf16x8){a[0], a[1], a[2], a[3], b[0], b[1], b[2], b[3]}; }
__device__ __forceinline__ bf16x8 pack8(f32x4 a, f32x4 b) { u32x4v w; w[0] = pg8::cvt_pk_bf16(a[0], a[1]); w[1] = pg8::cvt_pk_bf16(a[2], a[3]); w[2] = pg8::cvt_pk_bf16(b[0], b[1]); w[3] = pg8::cvt_pk_bf16(b[2], b[3]); return __builtin_bit_cast(bf16x8, w); }
__device__ __forceinline__ float rows4_max(float x) {
    auto r = __builtin_amdgcn_permlane16_swap(__float_as_uint(x), __float_as_uint(x), false, false); x = fmaxf(__uint_as_float(r[0]), __uint_as_float(r[1]));
    auto q = __builtin_amdgcn_permlane32_swap(__float_as_uint(x), __float_as_uint(x), false, false); return fmaxf(__uint_as_float(q[0]), __uint_as_float(q[1]));
}
__device__ __forceinline__ float rows4_sum(float x) {
    auto r = __builtin_amdgcn_permlane16_swap(__float_as_uint(x), __float_as_uint(x), false, false); x = __uint_as_float(r[0]) + __uint_as_float(r[1]);
    auto q = __builtin_amdgcn_permlane32_swap(__float_as_uint(x), __float_as_uint(x), false, false); return __uint_as_float(q[0]) + __uint_as_float(q[1]);
}
#define MFMA16(a, b, c) __builtin_amdgcn_mfma_f32_16x16x32_bf16(a, b, c, 0, 0, 0)
#define EXP2(x) __builtin_amdgcn_exp2f(x)
constexpr int KVS = 144;
constexpr int KVT = 128 * KVS;
#ifndef PFD
#define PFD 3
#endif

__device__ __forceinline__ void attn_mfma_item(int item, const bf16* P, bf16* MIX, const float* sink, LAS unsigned char* lds, int tid) {
    const int lane = tid & 63, wave = __builtin_amdgcn_readfirstlane(tid >> 6), g = wave >> 1, r0w = 64 * (item & 1) + 32 * (wave & 1);
    const int rb = item >> 2, hk = (item >> 1) & 1, hq = hk * 4 + g, l15 = lane & 15, lg = lane >> 4, q4 = (lane & 15) >> 2, p4 = lane & 3;
    const bool lat = rb < 256; const int bi = rb & 127;
    const int ng = lat ? 5 - (bi == 0 ? 1 : 0) - (bi == 127 ? 1 : 0) : 2;
    const int ctx0 = R_LAT + (lat ? (rb >> 7) : ((rb - 256) >> 1)) * 256;
    bf16x8 qf[2][2];
#pragma unroll
    for (int qt = 0; qt < 2; ++qt)
#pragma unroll
        for (int ks = 0; ks < 2; ++ks) qf[qt][ks] = *(const bf16x8*)(P + (size_t)(rb * 128 + r0w + 16 * qt + l15) * INW + C_AQ + hq * 64 + 32 * ks + 8 * lg);
#pragma unroll
    for (int qt = 0; qt < 2; ++qt)
#pragma unroll
        for (int ks = 0; ks < 2; ++ks) asm volatile("" : "+v"(qf[qt][ks]));
    f32x4 o[4][2];
#pragma unroll
    for (int i = 0; i < 4; ++i)
#pragma unroll
        for (int j = 0; j < 2; ++j) o[i][j] = (f32x4){0.f, 0.f, 0.f, 0.f};
    float m[2]; f32x4 lacc[2];
#pragma unroll
    for (int i = 0; i < 2; ++i) { m[i] = 0.f; lacc[i] = (f32x4){0.f, 0.f, 0.f, 0.f}; }
    bool fresh = true;
    constexpr float DEFER = 8.0f;
    const bf16x8 ones = (bf16x8){0x3F80, 0x3F80, 0x3F80, 0x3F80, 0x3F80, 0x3F80, 0x3F80, 0x3F80};
    const int skey = tid >> 2, spart = tid & 3;
    u32x4v rs[PFD][4];
#define ATT_GID(k) ((lat) ? (((k) + (bi == 0 ? 1 : 0)) + ((bi == 127 && ((k) + (bi == 0 ? 1 : 0)) >= 2) ? 1 : 0)) : (3 + (k)))
#define ATT_ROW0(id) ((id) == 0 ? (rb - 1) * 128 : ((id) == 1 ? rb * 128 : ((id) == 2 ? (rb + 1) * 128 : ctx0 + ((id) - 3) * 128)))
#define ATT_LOAD(k, S) do { const int id_ = ATT_GID(k); const bf16* kp_ = P + (size_t)(ATT_ROW0(id_) + skey) * INW + C_AK + hk * 64 + spart * 16; \
        rs[S][0] = *(const u32x4v*)kp_; rs[S][1] = *(const u32x4v*)(kp_ + 8); rs[S][2] = *(const u32x4v*)(kp_ + (C_AV - C_AK)); rs[S][3] = *(const u32x4v*)(kp_ + (C_AV - C_AK) + 8); } while (0)
#pragma unroll
    for (int k = 0; k < PFD; ++k) if (k < ng) ATT_LOAD(k, k);
#pragma unroll
    for (int k = 0; k < 5; ++k) if (k < ng) {
        LAS unsigned char* Kb = lds + (k & 1) * 2 * KVT; LAS unsigned char* Vb = Kb + KVT;
        { LAS unsigned char* d = Kb + skey * KVS + spart * 32; *(LAS u32x4v*)d = rs[k % PFD][0]; *(LAS u32x4v*)(d + 16) = rs[k % PFD][1]; d += KVT; *(LAS u32x4v*)d = rs[k % PFD][2]; *(LAS u32x4v*)(d + 16) = rs[k % PFD][3]; }
        __syncthreads();
        const int id = ATT_GID(k); const int mode = (id == 0) ? 1 : ((id == 2) ? 2 : 0);
        if (k + PFD < ng) ATT_LOAD(k + PFD, k % PFD);
#pragma unroll 1
        for (int sub = 0; sub < 2; ++sub) {
            if ((mode == 1 && sub == 0 && (item & 1)) || (mode == 2 && sub == 1 && !(item & 1))) continue;
            f32x4 s[4][2];
#pragma unroll
            for (int kt = 0; kt < 4; ++kt) {
                const LAS unsigned char* kr = Kb + (64 * sub + 16 * kt + l15) * KVS + 16 * lg;
                const bf16x8 kf0 = *(const LAS bf16x8*)kr, kf1 = *(const LAS bf16x8*)(kr + 64);
#pragma unroll
                for (int qt = 0; qt < 2; ++qt) { s[kt][qt] = MFMA16(kf0, qf[qt][0], ((f32x4){-m[qt], -m[qt], -m[qt], -m[qt]})); s[kt][qt] = MFMA16(kf1, qf[qt][1], s[kt][qt]); }
            }
            if (mode != 0) {
                const int mb = 64 * sub + 4 * lg - l15 - r0w;
                if (mode == 1) {
#pragma unroll
                    for (int kt = 0; kt < 4; ++kt)
#pragma unroll
                        for (int qt = 0; qt < 2; ++qt)
#pragma unroll
                            for (int r = 0; r < 4; ++r) s[kt][qt][r] = (mb >= -(16 * kt + r - 16 * qt)) ? s[kt][qt][r] : -INFINITY;
                } else {
#pragma unroll
                    for (int kt = 0; kt < 4; ++kt)
#pragma unroll
                        for (int qt = 0; qt < 2; ++qt)
#pragma unroll
                            for (int r = 0; r < 4; ++r) s[kt][qt][r] = (mb <= -(16 * kt + r - 16 * qt)) ? s[kt][qt][r] : -INFINITY;
                }
            }
            float mxq[2];
#pragma unroll
            for (int qt = 0; qt < 2; ++qt) {
                float mx = fmaxf(fmaxf(s[0][qt][0], s[0][qt][1]), fmaxf(s[0][qt][2], s[0][qt][3]));
#pragma unroll
                for (int kt = 1; kt < 4; ++kt) mx = fmaxf(mx, fmaxf(fmaxf(s[kt][qt][0], s[kt][qt][1]), fmaxf(s[kt][qt][2], s[kt][qt][3])));
                mxq[qt] = mx;
            }
            if (fresh || __builtin_amdgcn_ballot_w64(mxq[0] > DEFER || mxq[1] > DEFER) != 0ull) {
                mxq[0] = rows4_max(mxq[0]); mxq[1] = rows4_max(mxq[1]);
#pragma unroll
                for (int qt = 0; qt < 2; ++qt) {
                    const float d = fresh ? fmaxf(mxq[qt], -1e30f) : (mxq[qt] > DEFER ? mxq[qt] : 0.f);
                    m[qt] += d;
                    if (!fresh) { const float al = EXP2(-d); lacc[qt] = lacc[qt] * al;
#pragma unroll
                        for (int dvt = 0; dvt < 4; ++dvt) o[dvt][qt] = o[dvt][qt] * al; }
#pragma unroll
                    for (int kt = 0; kt < 4; ++kt)
#pragma unroll
                        for (int r = 0; r < 4; ++r) s[kt][qt][r] = EXP2(s[kt][qt][r] - d);
                }
            } else {
#pragma unroll
                for (int qt = 0; qt < 2; ++qt)
#pragma unroll
                    for (int kt = 0; kt < 4; ++kt)
#pragma unroll
                        for (int r = 0; r < 4; ++r) s[kt][qt][r] = EXP2(s[kt][qt][r]);
            }
            fresh = false;
#pragma unroll
            for (int ks = 0; ks < 2; ++ks) {
                bf16x8 pf[2];
#pragma unroll
                for (int qt = 0; qt < 2; ++qt) { pf[qt] = pack8(s[2 * ks][qt], s[2 * ks + 1][qt]); lacc[qt] = MFMA16(ones, pf[qt], lacc[qt]); }
#pragma unroll
                for (int dvt = 0; dvt < 4; ++dvt) {
                    const LAS unsigned char* vr = Vb + (64 * sub + 32 * ks + 4 * lg + q4) * KVS + (16 * dvt + 4 * p4) * 2;
                    const bf16x8 vf = cat8(tr16(vr), tr16(vr + 16 * KVS));
#pragma unroll
                    for (int qt = 0; qt < 2; ++qt) o[dvt][qt] = MFMA16(vf, pf[qt], o[dvt][qt]);
                }
            }
        }
    }
#undef ATT_GID
#undef ATT_ROW0
#undef ATT_LOAD
    const float sl = sink[hq] * LOG2E;
#pragma unroll
    for (int qt = 0; qt < 2; ++qt) {
        const float mf = fmaxf(m[qt], sl), al = EXP2(m[qt] - mf), den = lacc[qt][0] * al + EXP2(sl - mf), sc = al / den;
        bf16* op = MIX + (size_t)(rb * 128 + r0w + 16 * qt + l15) * DM + 256 + hq * 64 + 4 * lg;
#pragma unroll
        for (int dvt = 0; dvt < 4; ++dvt) { const f32x4 v = o[dvt][qt] * sc; u32x2v w; w[0] = pg8::cvt_pk_bf16(v[0], v[1]); w[1] = pg8::cvt_pk_bf16(v[2], v[3]); *(u32x2v*)(op + 16 * dvt) = w; }
    }
    __syncthreads();
}

__device__ __forceinline__ void reto_mfma_phase(const bf16* P, const bf16* SB, bf16* MIX, const float* norm_g, const float* decay_f, const float* decay_b, int n_items, int bid, int G, LAS unsigned char* lds, int tid) {
    const int lane = tid & 63, wave = __builtin_amdgcn_readfirstlane(tid >> 6), l15 = lane & 15, lg = lane >> 4, q4 = (lane & 15) >> 2, p4 = lane & 3;
    const int skey = tid >> 2, spart = tid & 3;
    LAS unsigned char* Kb = lds; LAS unsigned char* Vb = lds + KVT;
    u32x4v rs[PFD][4];
#define RO_LOAD(it_, S) do { const bf16* kp_ = P + (size_t)(((it_) >> 2) * 128 + skey) * INW + C_RK + ((it_) & 3) * 64 + spart * 16; \
        rs[S][0] = *(const u32x4v*)kp_; rs[S][1] = *(const u32x4v*)(kp_ + 8); rs[S][2] = *(const u32x4v*)(kp_ + (C_RV - C_RK)); rs[S][3] = *(const u32x4v*)(kp_ + (C_RV - C_RK) + 8); } while (0)
#pragma unroll
    for (int j = 0; j < PFD; ++j) if (bid + j * G < n_items) RO_LOAD(bid + j * G, j);
#pragma unroll
    for (int j = 0; j < 5; ++j) { const int it = bid + j * G; if (it < n_items) {
        const int ch = it >> 2, h = it & 3, i = 16 * wave + l15; const size_t row = (size_t)ch * 128 + i;
        const float df = decay_f[h], db = decay_b[h];
        bf16x8 qf[2], sf[4][2], sb[4][2]; u32x2v gw[4]; f32x4 ng[4];
#pragma unroll
        for (int ks = 0; ks < 2; ++ks) qf[ks] = *(const bf16x8*)(P + row * INW + C_RQ + h * 64 + 32 * ks + 8 * lg);
        { const bf16* Sf = SB + (size_t)(it * 2) * 4096; const bf16* Sb = Sf + 4096;
#pragma unroll
          for (int dvt = 0; dvt < 4; ++dvt)
#pragma unroll
              for (int ks = 0; ks < 2; ++ks) { const int so = (16 * dvt + l15) * 64 + 32 * ks + 8 * lg; sf[dvt][ks] = *(const bf16x8*)(Sf + so); sb[dvt][ks] = *(const bf16x8*)(Sb + so); } }
#pragma unroll
        for (int dvt = 0; dvt < 4; ++dvt) { const int dv0 = h * 64 + 16 * dvt + 4 * lg; gw[dvt] = *(const u32x2v*)(P + row * INW + C_RG + dv0); ng[dvt] = *(const f32x4*)(norm_g + dv0); }
        { LAS unsigned char* d = Kb + skey * KVS + spart * 32; *(LAS u32x4v*)d = rs[j % PFD][0]; *(LAS u32x4v*)(d + 16) = rs[j % PFD][1]; d += KVT; *(LAS u32x4v*)d = rs[j % PFD][2]; *(LAS u32x4v*)(d + 16) = rs[j % PFD][3]; }
        __syncthreads();
        f32x4 o[4], tf[4], tb[4];
#pragma unroll
        for (int d = 0; d < 4; ++d) { o[d] = (f32x4){0.f, 0.f, 0.f, 0.f}; tf[d] = o[d]; tb[d] = o[d]; }
#pragma unroll
        for (int dvt = 0; dvt < 4; ++dvt)
#pragma unroll
            for (int ks = 0; ks < 2; ++ks) { tf[dvt] = MFMA16(sf[dvt][ks], qf[ks], tf[dvt]); tb[dvt] = MFMA16(sb[dvt][ks], qf[ks], tb[dvt]); }
#pragma unroll
        for (int d = 0; d < 4; ++d) asm volatile("" : "+v"(tf[d]), "+v"(tb[d]));
        if (it + PFD * G < n_items) RO_LOAD(it + PFD * G, j % PFD);
        const float l2f = df, l2b = db;
        f32x4 s[8];
#pragma unroll
        for (int jt = 0; jt < 8; ++jt) { const LAS unsigned char* kr = Kb + (16 * jt + l15) * KVS + 16 * lg;
            s[jt] = MFMA16(*(const LAS bf16x8*)kr, qf[0], ((f32x4){0.f, 0.f, 0.f, 0.f})); s[jt] = MFMA16(*(const LAS bf16x8*)(kr + 64), qf[1], s[jt]); }
#pragma unroll
        for (int jt = 0; jt < 8; ++jt)
#pragma unroll
            for (int r = 0; r < 4; ++r) { const int jj = 16 * jt + 4 * lg + r; const int dd = i - jj; const float e = EXP2((float)(dd < 0 ? -dd : dd) * (dd < 0 ? l2b : l2f)); s[jt][r] *= (dd == 0) ? 2.0f : e; }
#pragma unroll
        for (int ks = 0; ks < 4; ++ks) { const bf16x8 pf = pack8(s[2 * ks], s[2 * ks + 1]);
#pragma unroll
            for (int dvt = 0; dvt < 4; ++dvt) { const LAS unsigned char* vr = Vb + (32 * ks + 4 * lg + q4) * KVS + (16 * dvt + 4 * p4) * 2;
                o[dvt] = MFMA16(cat8(tr16(vr), tr16(vr + 16 * KVS)), pf, o[dvt]); } }
        const float qdf = EXP2((float)(i + 1) * l2f), qdb = EXP2((float)(128 - i) * l2b);
        float sum = 0.f;
#pragma unroll
        for (int d = 0; d < 4; ++d) { o[d] = o[d] + tf[d] * qdf + tb[d] * qdb; sum += (o[d][0] + o[d][1]) + (o[d][2] + o[d][3]); }
        sum = rows4_sum(sum);
        const float mu = sum * (1.0f / 64.0f); float qq = 0.f;
#pragma unroll
        for (int d = 0; d < 4; ++d) { o[d] = o[d] - mu; qq += (o[d][0] * o[d][0] + o[d][1] * o[d][1]) + (o[d][2] * o[d][2] + o[d][3] * o[d][3]); }
        qq = rows4_sum(qq);
        const float rstd = __builtin_amdgcn_rsqf(qq * (1.0f / 64.0f) + EPS);
#pragma unroll
        for (int dvt = 0; dvt < 4; ++dvt) { const int dv0 = h * 64 + 16 * dvt + 4 * lg;
            const f32x4 gt = (f32x4){bf_lo(gw[dvt][0]), bf_hi(gw[dvt][0]), bf_lo(gw[dvt][1]), bf_hi(gw[dvt][1])};
            const f32x4 v = o[dvt] * rstd * ng[dvt] * gt; u32x2v w; w[0] = pg8::cvt_pk_bf16(v[0], v[1]); w[1] = pg8::cvt_pk_bf16(v[2], v[3]);
            *(u32x2v*)(MIX + row * DM + dv0) = w; }
        __syncthreads();
    } }
#undef RO_LOAD
}

__device__ __forceinline__ void retd_mfma_phase(const bf16* P, float* DB, const float* decay_f, const float* decay_b, int it0, int n_items, int G, LAS unsigned char* lds, int tid) {
    const int lane = tid & 63, wave = __builtin_amdgcn_readfirstlane(tid >> 6), l15 = lane & 15, lg = lane >> 4, q4 = (lane & 15) >> 2, p4 = lane & 3;
    const int skey = tid >> 2, spart = tid & 3, dir = wave & 1, dvt = wave >> 1;
    u32x4v rk0, rk1, rv0, rv1;
#define RD_LOAD(it_) do { const bf16* kp_ = P + (size_t)(((it_) >> 2) * 128 + skey) * INW + C_RK + ((it_) & 3) * 64 + spart * 16; \
        rk0 = *(const u32x4v*)kp_; rk1 = *(const u32x4v*)(kp_ + 8); rv0 = *(const u32x4v*)(kp_ + (C_RV - C_RK)); rv1 = *(const u32x4v*)(kp_ + (C_RV - C_RK) + 8); } while (0)
    if (it0 < n_items) RD_LOAD(it0);
    for (int it = it0; it < n_items; it += G) {
        const int h = it & 3;
        const float l2f = decay_f[h], l2b = decay_b[h];
        { const float wf = EXP2((float)(127 - skey) * l2f), wb = EXP2((float)skey * l2b);
          float t[16]; UNPACK8(t, 0, rk0); UNPACK8(t, 8, rk1);
          u32x4v a0, a1, b0, b1;
#pragma unroll
          for (int e = 0; e < 4; ++e) { a0[e] = pg8::cvt_pk_bf16(t[2 * e] * wf, t[2 * e + 1] * wf); a1[e] = pg8::cvt_pk_bf16(t[8 + 2 * e] * wf, t[9 + 2 * e] * wf);
              b0[e] = pg8::cvt_pk_bf16(t[2 * e] * wb, t[2 * e + 1] * wb); b1[e] = pg8::cvt_pk_bf16(t[8 + 2 * e] * wb, t[9 + 2 * e] * wb); }
          LAS unsigned char* d = lds + skey * KVS + spart * 32; *(LAS u32x4v*)d = a0; *(LAS u32x4v*)(d + 16) = a1; d += KVT; *(LAS u32x4v*)d = b0; *(LAS u32x4v*)(d + 16) = b1;
          d += KVT; *(LAS u32x4v*)d = rv0; *(LAS u32x4v*)(d + 16) = rv1; }
        __syncthreads();
        if (it + G < n_items) RD_LOAD(it + G);
        f32x4 acc[4];
#pragma unroll
        for (int d = 0; d < 4; ++d) acc[d] = (f32x4){0.f, 0.f, 0.f, 0.f};
        const LAS unsigned char* Kt = lds + dir * KVT; const LAS unsigned char* Vt = lds + 2 * KVT;
#pragma unroll
        for (int ks = 0; ks < 4; ++ks) { const int ro = (32 * ks + 4 * lg + q4) * KVS + 8 * p4;
            const bf16x8 vf = cat8(tr16(Vt + ro + 32 * dvt), tr16(Vt + ro + 32 * dvt + 16 * KVS));
#pragma unroll
            for (int dkt = 0; dkt < 4; ++dkt) acc[dkt] = MFMA16(vf, cat8(tr16(Kt + ro + 32 * dkt), tr16(Kt + ro + 32 * dkt + 16 * KVS)), acc[dkt]); }
        float* Dp = DB + (size_t)(it * 2 + dir) * 4096 + (16 * dvt + 4 * lg) * 64 + l15;
#pragma unroll
        for (int dkt = 0; dkt < 4; ++dkt)
#pragma unroll
            for (int r = 0; r < 4; ++r) Dp[r * 64 + 16 * dkt] = acc[dkt][r];
        __syncthreads();
    }
#undef RD_LOAD
}

__device__ __forceinline__ void gmlp_mfma_item(int ch, const bf16* P, bf16* MIX, const float* norm_g, const bf16* WS, const float* b_s, LAS unsigned char* lds, int tid) {
    const int lane = tid & 63, wave = __builtin_amdgcn_readfirstlane(tid >> 6), l15 = lane & 15, lg = lane >> 4, q4 = (lane & 15) >> 2, p4 = lane & 3;
    const int gW = wave >> 1, p0W = 64 * (wave & 1);
    bf16x8 wfa[4][4];
#pragma unroll
    for (int ks = 0; ks < 4; ++ks)
#pragma unroll
        for (int pt = 0; pt < 4; ++pt) wfa[ks][pt] = *(const bf16x8*)(WS + (size_t)gW * 16384 + (size_t)(p0W + 16 * pt + l15) * 128 + 32 * ks + 8 * lg);
    { const int g = tid >> 7, q = tid & 127; float v[64]; const u32x4v* vp = (const u32x4v*)(P + (size_t)(ch * 128 + q) * INW + C_CV + g * 64);
#pragma unroll
      for (int i = 0; i < 8; ++i) { const u32x4v w = vp[i]; UNPACK8(v, 8 * i, w); }
      float s = 0.f;
#pragma unroll
      for (int d = 0; d < 64; ++d) s += v[d];
      const float mu = s * (1.0f / 64.0f); float qq = 0.f;
#pragma unroll
      for (int d = 0; d < 64; ++d) { v[d] -= mu; qq += v[d] * v[d]; }
      const float rstd = __builtin_amdgcn_rsqf(qq * (1.0f / 64.0f) + EPS);
      LAS unsigned char* dst = lds + g * KVT + q * KVS;
#pragma unroll
      for (int i = 0; i < 8; ++i) { const f32x4 n0 = *(const f32x4*)(norm_g + g * 64 + 8 * i), n1 = *(const f32x4*)(norm_g + g * 64 + 8 * i + 4); u32x4v w;
          w[0] = pg8::cvt_pk_bf16(v[8 * i] * rstd * n0[0], v[8 * i + 1] * rstd * n0[1]); w[1] = pg8::cvt_pk_bf16(v[8 * i + 2] * rstd * n0[2], v[8 * i + 3] * rstd * n0[3]);
          w[2] = pg8::cvt_pk_bf16(v[8 * i + 4] * rstd * n1[0], v[8 * i + 5] * rstd * n1[1]); w[3] = pg8::cvt_pk_bf16(v[8 * i + 6] * rstd * n1[2], v[8 * i + 7] * rstd * n1[3]);
          *(LAS u32x4v*)(dst + 16 * i) = w; } }
    __syncthreads();
    const int g = wave >> 1, p0 = 64 * (wave & 1);
    const LAS unsigned char* Vn = lds + g * KVT; const bf16* W = WS + (size_t)g * 16384;
    f32x4 acc[4][4];
#pragma unroll
    for (int i = 0; i < 4; ++i)
#pragma unroll
        for (int j = 0; j < 4; ++j) acc[i][j] = (f32x4){0.f, 0.f, 0.f, 0.f};
#pragma unroll
    for (int ks = 0; ks < 4; ++ks) {
        bf16x8 wf[4], vf[4];
#pragma unroll
        for (int pt = 0; pt < 4; ++pt) wf[pt] = wfa[ks][pt];
#pragma unroll
        for (int dt = 0; dt < 4; ++dt) { const LAS unsigned char* vr = Vn + (32 * ks + 8 * lg + q4) * KVS + (16 * dt + 4 * p4) * 2; vf[dt] = cat8(tr16(vr), tr16(vr + 4 * KVS)); }
#pragma unroll
        for (int dt = 0; dt < 4; ++dt)
#pragma unroll
            for (int pt = 0; pt < 4; ++pt) acc[dt][pt] = MFMA16(vf[dt], wf[pt], acc[dt][pt]);
    }
#pragma unroll
    for (int pt = 0; pt < 4; ++pt) { const int p = p0 + 16 * pt + l15; const size_t row = (size_t)ch * 128 + p; const float bs = b_s[g * 128 + p];
#pragma unroll
        for (int dt = 0; dt < 4; ++dt) { const int c0 = g * 64 + 16 * dt + 4 * lg; const u32x2v uw = *(const u32x2v*)(P + row * INW + C_CU + c0);
            const f32x4 uu = (f32x4){bf_lo(uw[0]), bf_hi(uw[0]), bf_lo(uw[1]), bf_hi(uw[1])}; const f32x4 v = uu * (acc[dt][pt] + bs);
            u32x2v w; w[0] = pg8::cvt_pk_bf16(v[0], v[1]); w[1] = pg8::cvt_pk_bf16(v[2], v[3]); *(u32x2v*)(MIX + row * DM + 768 + c0) = w; } }
    __syncthreads();
}

template <int MODE> __device__ __forceinline__ void ctx_gemm(const bf16* A  , int K, const bf16* Bt, float* X, const float* Xsrc, const float* gate, float sgn, bf16* H, int bid, int G, LAS unsigned char* lds, int tid) {
    const int lane = tid & 63, wave = __builtin_amdgcn_readfirstlane(tid >> 6), l15 = lane & 15, lg = lane >> 4;
    const int ntile = MODE == 0 ? 256 : 1408, ksz = K >> 3, nks = ksz >> 5;
    for (int tile = bid; tile < ntile; tile += G) {
        int row0, brow[4];
        if (MODE == 0) { row0 = (tile >> 4) * 32; const int n0 = (tile & 15) * 64;
#pragma unroll
            for (int ct = 0; ct < 4; ++ct) brow[ct] = n0 + 16 * ct + l15; }
        else { row0 = (tile / 88) * 32; const int hb = tile % 88, n0 = 256 * (hb >> 2) + 32 * (hb & 3);
#pragma unroll
            for (int ct = 0; ct < 4; ++ct) brow[ct] = n0 + 128 * (ct >> 1) + 16 * (ct & 1) + l15; }
        f32x4 acc[2][4];
#pragma unroll
        for (int i = 0; i < 2; ++i)
#pragma unroll
            for (int j = 0; j < 4; ++j) acc[i][j] = (f32x4){0.f, 0.f, 0.f, 0.f};
        const bf16* ap = A + (size_t)(row0 + l15) * K + wave * ksz + 8 * lg;
        const bf16* bp0 = Bt + (size_t)brow[0] * K + wave * ksz + 8 * lg; const bf16* bp1 = Bt + (size_t)brow[1] * K + wave * ksz + 8 * lg;
        const bf16* bp2 = Bt + (size_t)brow[2] * K + wave * ksz + 8 * lg; const bf16* bp3 = Bt + (size_t)brow[3] * K + wave * ksz + 8 * lg;
#pragma unroll 4
        for (int ks = 0; ks < nks; ++ks) {
            const bf16x8 a0 = *(const bf16x8*)(ap + 32 * ks), a1 = *(const bf16x8*)(ap + (size_t)16 * K + 32 * ks);
            const bf16x8 b0 = *(const bf16x8*)(bp0 + 32 * ks), b1 = *(const bf16x8*)(bp1 + 32 * ks), b2 = *(const bf16x8*)(bp2 + 32 * ks), b3 = *(const bf16x8*)(bp3 + 32 * ks);
            acc[0][0] = MFMA16(b0, a0, acc[0][0]); acc[0][1] = MFMA16(b1, a0, acc[0][1]); acc[0][2] = MFMA16(b2, a0, acc[0][2]); acc[0][3] = MFMA16(b3, a0, acc[0][3]);
            acc[1][0] = MFMA16(b0, a1, acc[1][0]); acc[1][1] = MFMA16(b1, a1, acc[1][1]); acc[1][2] = MFMA16(b2, a1, acc[1][2]); acc[1][3] = MFMA16(b3, a1, acc[1][3]);
        }
        LAS f32x4* red = (LAS f32x4*)lds;
#pragma unroll
        for (int rt = 0; rt < 2; ++rt)
#pragma unroll
            for (int ct = 0; ct < 4; ++ct) red[((wave * 2 + rt) * 4 + ct) * 64 + lane] = acc[rt][ct];
        __syncthreads();
        if (MODE == 0) {
            const int slot = tid >> 6, rt = slot >> 2, ct = slot & 3;
            f32x4 v = red[slot * 64 + lane];
#pragma unroll
            for (int w = 1; w < 8; ++w) v += red[(w * 8 + slot) * 64 + lane];
            const int row = row0 + 16 * rt + l15, col = (tile & 15) * 64 + 16 * ct + 4 * lg;
            f32x4* xp = (f32x4*)(X + (size_t)(R_LAT + row) * DM + col); *xp = *(const f32x4*)(Xsrc + (size_t)row * DM + col) + *(const f32x4*)(gate + col) * v * sgn;
        } else if (tid < 256) {
            const int slot = tid >> 6, rt = slot >> 1, cg = slot & 1;
            f32x4 gv = red[((rt * 4) + cg) * 64 + lane], uv = red[((rt * 4) + cg + 2) * 64 + lane];
#pragma unroll
            for (int w = 1; w < 8; ++w) { gv += red[((w * 2 + rt) * 4 + cg) * 64 + lane]; uv += red[((w * 2 + rt) * 4 + cg + 2) * 64 + lane]; }
            const int hb = tile % 88, row = row0 + 16 * rt + l15, hid = 32 * hb + 16 * cg + 4 * lg;
            f32x4 hv;
#pragma unroll
            for (int j = 0; j < 4; ++j) hv[j] = pg8::silu_f(gv[j]) * uv[j];
            u32x2v w; w[0] = pg8::cvt_pk_bf16(hv[0], hv[1]); w[1] = pg8::cvt_pk_bf16(hv[2], hv[3]);
            *(u32x2v*)(H + (size_t)(R_LAT + row) * FF + hid) = w;
        }
        __syncthreads();
    }
}

#define XB_TMO      128
#define XB_XCNT(j)  (256  + 64 * (j))
#define XB_XSUB(j)  (1280 + 64 * (j))
#define XB_XGEN(j)  (2304 + 64 * (j))
#define XB_TOP      3328
#define XB_TOPGEN   3392
#define XCD_BAR_WORDS 3456
#define XB_SPIN_CAP (1u << 18)

__device__ __forceinline__ unsigned xb_ld(unsigned* p)              { return __hip_atomic_load(p, __ATOMIC_RELAXED, __HIP_MEMORY_SCOPE_AGENT); }
__device__ __forceinline__ unsigned xb_add(unsigned* p, unsigned v) { return __hip_atomic_fetch_add(p, v, __ATOMIC_RELAXED, __HIP_MEMORY_SCOPE_AGENT); }
__device__ __forceinline__ unsigned xb_xcc_id() { return (unsigned)__builtin_amdgcn_s_getreg((3 << 11) | 20) & 0xFu; }
#define XB_SPIN(cond, bar) do { unsigned _sp = 0; while (cond) { __builtin_amdgcn_s_sleep(1); \
    if ((++_sp & 255u) == 0u) { if (xb_ld(&(bar)[XB_TMO])) break; if (_sp > XB_SPIN_CAP) { atomicAdd(&(bar)[XB_TMO], 1u); break; } } } } while (0)

struct XcdBarrier {
    unsigned* bar; unsigned x;
    volatile LAS unsigned* st;
};

__device__ __forceinline__ XcdBarrier xcd_barrier_post(unsigned* bar, volatile LAS unsigned* st) {
    XcdBarrier b; b.bar = bar; b.x = xb_xcc_id(); b.st = st;
    if (threadIdx.x == 0) (void)xb_add(&bar[XB_XCNT(b.x)], 1u);
    return b;
}
__device__ __forceinline__ void xcd_barrier_complete(unsigned* bar, unsigned x, unsigned& nloc, unsigned& nx) {
    const unsigned G = gridDim.x * gridDim.y * gridDim.z;
    unsigned sum, cnt, mine, sp = 0u;
    for (;;) {
        sum = 0u; cnt = 0u; mine = 0u;
#pragma unroll
        for (unsigned j = 0; j < 16; ++j) { const unsigned c = xb_ld(&bar[XB_XCNT(j)]); sum += c; cnt += (c > 0u) ? 1u : 0u; mine = (j == x) ? c : mine; }
        if (sum == G) break;
        __builtin_amdgcn_s_sleep(1);
        if ((++sp & 255u) == 0u) { if (xb_ld(&bar[XB_TMO])) break; if (sp > XB_SPIN_CAP) { atomicAdd(&bar[XB_TMO], 1u); break; } }
    }
    nloc = mine > 0u ? mine : 1u; nx = cnt > 0u ? cnt : 1u;
}

__device__ __forceinline__ void xcd_barrier(const XcdBarrier& b) {
    asm volatile("s_waitcnt vmcnt(0)" ::: "memory");
    __syncthreads();
    if (threadIdx.x == 0) {
        unsigned* bar = b.bar;
        __builtin_amdgcn_s_waitcnt(0);
        unsigned nloc = b.st[0], nx = b.st[1];
        if (nloc == 0u) { xcd_barrier_complete(bar, b.x, nloc, nx); b.st[0] = nloc; b.st[1] = nx; }
        const unsigned old = xb_add(&bar[XB_XSUB(b.x)], 1u);
        const unsigned gen = old / nloc;
        if (old + 1u == (gen + 1u) * nloc) {
            __builtin_amdgcn_fence(__ATOMIC_RELEASE, "agent");
            asm volatile("s_waitcnt vmcnt(0)" ::: "memory");
            const unsigned og = xb_add(&bar[XB_TOP], 1u);
            const unsigned tg = og / nx;
            if (og + 1u == (tg + 1u) * nx) xb_add(&bar[XB_TOPGEN], 1u);
            else XB_SPIN(xb_ld(&bar[XB_TOPGEN]) == tg, bar);
            __builtin_amdgcn_fence(__ATOMIC_ACQUIRE, "agent");
            xb_add(&bar[XB_XGEN(b.x)], 1u);
            asm volatile("s_waitcnt vmcnt(0)" ::: "memory");
        } else {
            XB_SPIN(xb_ld(&bar[XB_XGEN(b.x)]) == gen, bar);
            __builtin_amdgcn_fence(__ATOMIC_ACQUIRE, "agent");
            asm volatile("s_waitcnt vmcnt(0)" ::: "memory");
        }
    }
    __syncthreads();
}

#ifndef EPIRES_ALIGN
#define EPIRES_ALIGN true
#endif
#ifndef REP_MASK
#define REP_MASK 0
#endif
#ifndef SYNC_REP
#define SYNC_REP 1
#endif
#ifndef PHMASK
#define PHMASK 255
#endif
constexpr int N_PHASES = 2 + 9 * DEPTH;
__global__ void __launch_bounds__(NT, 2) fwd_kernel(Args a_unused) {
    extern __shared__ __attribute__((aligned(16))) unsigned char lds_raw[];
    LAS unsigned char* lds = (LAS unsigned char*)lds_raw;
    cg::grid_group grid = cg::this_grid();
    const int G = gridDim.x, bid = blockIdx.x, ngw = G * NWAVES;
    volatile LAS unsigned* MISC = (volatile LAS unsigned*)(lds + 131072);
    if (threadIdx.x < 64) MISC[threadIdx.x] = 0u;
    __syncthreads();
    XcdBarrier xbar = xcd_barrier_post((unsigned*)(a_unused.ws + WS_BAR), MISC + 8);
    const int ph_lo = a_unused.ph_lo, ph_hi = a_unused.ph_hi, rep_mask = a_unused.rep_mask, sync_rep = a_unused.sync_rep;
    int rep = 0;
    for (int ph = ph_lo; ph < ph_hi;) {
        KArgs a = (KArgs)__builtin_amdgcn_kernarg_segment_ptr(); asm volatile("" : "+s"(a));
        unsigned char* ws = a->ws;
        float* MOD = (float*)(ws + WS_MOD); float* ROPE = (float*)(ws + WS_ROPE);
        float* XRES = (float*)(ws + WS_X); bf16* ZM = (bf16*)(ws + WS_ZM); bf16* PH = (bf16*)(ws + WS_PH);
        float* DB = (float*)(ws + WS_D); bf16* SB = (bf16*)(ws + WS_S); float* DEC = (float*)(ws + WS_DEC);
        int tid = threadIdx.x; asm volatile("" : "+v"(tid));
        const int lane = tid & 63, wave = __builtin_amdgcn_readfirstlane(tid >> 6), gw = bid * NWAVES + wave;
        if (ph == 0) {
            for (int i = bid * NT + tid; i < 4096; i += G * NT) { const int pos = i >> 4, j = i & 15; const float inv = exp2f(-(float)j * (13.287712379549449f / 16.0f)); const float ang = (float)pos * inv;
                ROPE[2 * i] = __cosf(ang); ROPE[2 * i + 1] = __sinf(ang); }
            if (bid == 0 && tid < 32) { const int l_ = tid >> 3, d_ = (tid >> 2) & 1, h_ = tid & 3; DEC[tid] = log_sigmoid_f((d_ ? a->ret_decay_b : a->ret_decay_f)[l_ * 4 + h_]) * LOG2E; }
            mod_phase(a, MOD, lds, bid, G, tid);
            __syncthreads();
            convert_weights(a, 0, ws + WS_W0, lds, gw, ngw, wave, lane);
        } else if (ph == N_PHASES - 1) {
            norm_phase<2>(a, XRES, ZM, a->final_norm_g, MOD, R_LAT, gw, ngw, lane);
        } else {
            const int l = (ph - 1) / 9, k = (ph - 1) % 9; const bool last = (l == DEPTH - 1);
            unsigned char* wb = ws + WS_W0 + (size_t)(l & 1) * WBUF_BYTES;
            const float* modl = MOD + (size_t)l * 3 * 6144;
            const int rows_out = last ? R_LAT : R_ALL;
            if (k == 0) {
                if (l == 0) norm_phase<1>(a, XRES, ZM, a->norm1_g, modl, R_ALL, gw, ngw, lane);
                else norm_phase<0>(a, XRES, ZM, a->norm1_g + l * DM, modl, R_ALL, gw, ngw, lane);
            } else if (k == 1 || k == 5 || k == 7 || k == 8) {
                const int gm = (k == 1 || (k == 7 && !last)) ? R_ALL : R_LAT, gn = (k == 1) ? INW : (k == 7 ? GUW : DM), gk = (k == 8) ? FF : DM;
                const bf16* gA = (k == 8) ? PH : ZM;
                const bf16* gB = (const bf16*)(wb + (k == 1 ? WO_IN : (k == 5 ? WO_OUT : (k == 7 ? WO_GU : WO_DN))));
                pg8::Gemm g{gA, gB, gm, gn, gk}; pg8::StaticOrder S; S.init(gm, gn, G, bid);
                pg8::EpiAll E{(k == 1) ? 0 : (k == 7 ? 2 : 1), true, (k == 1 || k == 7) || EPIRES_ALIGN, pg8::EpiIn{PH, ROPE}, pg8::EpiRes{XRES, (l == 0 && k == 5) ? a->x : (const float*)XRES, modl + (k == 5 ? 2 * 1024 : 5 * 1024), (rep == 1) ? -1.0f : 1.0f}, pg8::EpiGU{PH}};
#if PHMASK & 1
                pg8::gemm_phase<pg8::EpiAll, pg8::StaticOrder, true, true>(lds, g, S, E);
#endif
                if (!last && (k == 5 || k == 8)) {
                    ctx_gemm<0>(gA + (size_t)R_LAT * gk, gk, gB, XRES, (l == 0 && k == 5) ? a->ctx : (const float*)(XRES + (size_t)R_LAT * DM), modl + 2 * 6144 + (k == 5 ? 2 * 1024 : 5 * 1024), (rep == 1) ? -1.0f : 1.0f, PH, bid, G, lds, tid);
                }
            } else if (k == 2) {
                const int n_att = last ? 1024 : 1040, n_cm = last ? 256 : 260, n_d = NCHUNK * 4;
                for (int rr = 0; rr < 1 + ((rep_mask >> 10) & 1); ++rr)
                for (int it = bid; it < n_att; it += G) attn_mfma_item(it, PH, ZM, a->attn_sink + l * 8, lds, tid);
                const int o1 = (G - (n_att % G)) % G;
                for (int rr = 0; rr < 1 + ((rep_mask >> 11) & 1); ++rr)
                for (int it = (bid + o1) % G; it < n_cm; it += G) gmlp_mfma_item(it, PH, ZM, a->cm_norm_g + l * 256, (const bf16*)(wb + WO_WS), a->cm_b_s + l * 512, lds, tid);
                const int o2 = (o1 + G - (n_cm % G)) % G;
                for (int rr = 0; rr < 1 + ((rep_mask >> 12) & 1); ++rr)
                retd_mfma_phase(PH, DB, DEC + l * 8, DEC + l * 8 + 4, (bid + o2) % G, n_d, G, lds, tid);
            } else if (k == 3) {
                scan_phase(DB, SB, DEC + l * 8, DEC + l * 8 + 4, bid * NT + tid, G * NT);
                if (!last) { const int w0 = (65536 / NT < G) ? (65536 / NT) * NWAVES : 0;
                    if (gw >= w0) convert_weights(a, l + 1, ws + WS_W0 + (size_t)((l + 1) & 1) * WBUF_BYTES, lds, gw - w0, ngw - w0, wave, lane); }
            } else if (k == 4) {
                reto_mfma_phase(PH, SB, ZM, a->ret_norm_g + l * 256, DEC + l * 8, DEC + l * 8 + 4, (last ? 256 : 260) * 4, bid, G, lds, tid);
            } else if (k == 6) {
                norm_phase<0>(a, XRES, ZM, a->norm2_g + l * DM, modl + 3 * 1024, rows_out, gw, ngw, lane);
            }
        }
        if (ph + 1 < ph_hi) { for (int sr = 0; sr < sync_rep; ++sr) { if (ph_hi > 100000) grid.sync(); else xcd_barrier(xbar); } }
        { const int kk = (ph == 0) ? 9 : (ph - 1) % 9; const int nrep = (ph < N_PHASES - 1 && ((rep_mask >> kk) & 1)) ? ((kk == 5 || kk == 8) ? 3 : 2) : 1;
          if (rep + 1 < nrep) ++rep; else { rep = 0; ++ph; } }
    }
}

#ifndef MK_MULTI
#define MK_MULTI 0
#endif
extern "C" void kernel_launch(void* const* d_in, const int* in_sizes, int n_in, void* d_out, int out_size, void* d_ws, size_t ws_size, hipStream_t stream) {
    static int grid = 0;
    if (grid == 0) {
        if (n_in != 21 || ws_size < WS_END) { fprintf(stderr, "kernel_launch: unexpected n_in %d or ws_size %zu (< %zu)\n", n_in, ws_size, (size_t)WS_END); grid = -1; return; }
        int dev = 0, cus = 0;
        if (hipGetDevice(&dev) != hipSuccess || hipDeviceGetAttribute(&cus, hipDeviceAttributeMultiprocessorCount, dev) != hipSuccess) { grid = -1; return; }
        if (hipFuncSetAttribute((const void*)fwd_kernel, hipFuncAttributeMaxDynamicSharedMemorySize, LDS_BYTES) != hipSuccess) { fprintf(stderr, "kernel_launch: hipFuncSetAttribute failed\n"); grid = -1; return; }
        int per_cu = 0;
        if (hipOccupancyMaxActiveBlocksPerMultiprocessor(&per_cu, (const void*)fwd_kernel, NT, LDS_BYTES) != hipSuccess || per_cu < 1) { fprintf(stderr, "kernel_launch: occupancy query says %d\n", per_cu); per_cu = 1; }
        (void)hipGetLastError();
        grid = cus;
    }
    if (grid < 0) return;
    if (hipMemsetAsync((char*)d_ws + WS_BAR, 0, BAR_ZERO_BYTES, stream) != hipSuccess) { fprintf(stderr, "kernel_launch: memset failed\n"); return; }
    Args a{};
    const float** ap = (const float**)&a;
    for (int i = 0; i < 21; ++i) ap[i] = (const float*)d_in[i];
    a.out = (float*)d_out; a.ws = (unsigned char*)d_ws; a.rep_mask = REP_MASK; a.sync_rep = SYNC_REP;
#if MK_MULTI
    for (int ph = 0; ph < N_PHASES; ++ph) { a.ph_lo = ph; a.ph_hi = ph + 1; hipLaunchKernelGGL(fwd_kernel, dim3(grid), dim3(NT), LDS_BYTES, stream, a); }
#else
    a.ph_lo = 0; a.ph_hi = N_PHASES;
    void* args[] = {&a};
    hipError_t e = hipLaunchCooperativeKernel((const void*)fwd_kernel, dim3(grid), dim3(NT), args, LDS_BYTES, stream);
    if (e != hipSuccess) fprintf(stderr, "cooperative launch failed: %s (grid %d)\n", hipGetErrorString(e), grid);
#endif
}
```
